# Optimizing an MI355X kernel written in HIP

```python
import jax, jax.numpy as jnp
from jax import lax
import numpy as np

D_MODEL = 1024
BATCH = 4
SEQ = 4096
DEPTH = 1

HEAD_DIM = 128
DSA_HEADS = 4
MOBA_HEADS = 4
IDX_HEADS = 8
IDX_DIM = 64
DSA_TOPK_MAX = 256
MOBA_BLOCK = 256
MOBA_TOPK = 3
D_FF = -(-8 * D_MODEL // 768) * 256
ROPE_THETA = 10000.0
EPS = 1e-6
NEG = -1e30
DSA_Q_BLOCK = 128
MOBA_Q_BLOCK = 32
DSA_W = DSA_HEADS * HEAD_DIM
MOBA_W = MOBA_HEADS * HEAD_DIM
IN_SIZES = (DSA_W, DSA_W, DSA_W, IDX_HEADS * IDX_DIM, IDX_DIM, IDX_HEADS,
            MOBA_W, MOBA_W, MOBA_W, D_MODEL, D_MODEL)
IN_W = sum(IN_SIZES)
N_MOD = 6

kernel_name = "hybrid_dsa_moba_gated_block"


def rms_norm(x, gain):
    xf = x.astype(jnp.float32)
    y = xf * lax.rsqrt(jnp.mean(xf * xf, axis=-1, keepdims=True) + EPS)
    return (y * gain.astype(jnp.float32)).astype(x.dtype)


def rope_tables(seq, dim):
    inv = ROPE_THETA ** (-jnp.arange(0, dim, 2, dtype=jnp.float32) / dim)
    ang = jnp.arange(seq, dtype=jnp.float32)[:, None] * inv[None, :]
    return jnp.cos(ang)[:, None, :], jnp.sin(ang)[:, None, :]


def apply_rope(x, cos, sin):
    x1, x2 = jnp.split(x.astype(jnp.float32), 2, axis=-1)
    return jnp.concatenate([x1 * cos - x2 * sin, x2 * cos + x1 * sin], axis=-1).astype(x.dtype)


def dsa_attention(q, k, v, qi, ki, wi):
    B, S, H, Dh = q.shape
    topk = min(DSA_TOPK_MAX, S // 4)
    nq = S // DSA_Q_BLOCK
    scale = Dh ** -0.5
    key_pos = jnp.arange(S)
    bi = jnp.arange(B)[:, None, None]

    def chunks(a):
        return jnp.moveaxis(a.reshape(a.shape[0], nq, DSA_Q_BLOCK, *a.shape[2:]), 1, 0)

    def block(args):
        qb, qib, wib, t = args
        logits = jnp.einsum('bqhd,bsd->bqhs', qib, ki).astype(jnp.float32)
        score = jnp.einsum('bqh,bqhs->bqs', wib.astype(jnp.float32), jax.nn.relu(logits))
        score = jnp.where((key_pos[None, :] <= t[:, None])[None], score, NEG)
        _, sel = lax.top_k(score, topk)
        ks = k[bi, sel]
        vs = v[bi, sel]
        s = jnp.einsum('bqhd,bqkhd->bhqk', qb, ks).astype(jnp.float32) * scale
        valid = sel <= t[None, :, None]
        s = jnp.where(valid[:, None], s, NEG)
        p = jax.nn.softmax(s, axis=-1).astype(v.dtype)
        return jnp.einsum('bhqk,bqkhd->bqhd', p, vs)

    t_c = jnp.arange(S).reshape(nq, DSA_Q_BLOCK)
    out = lax.map(block, (chunks(q), chunks(qi), chunks(wi), t_c))
    return jnp.moveaxis(out, 0, 1).reshape(B, S, H * Dh)


def moba_attention(q, k, v):
    B, S, H, Dh = q.shape
    nb = -(-S // MOBA_BLOCK)
    pad = nb * MOBA_BLOCK - S
    scale = Dh ** -0.5
    qh = q.transpose(0, 2, 1, 3)
    padw = ((0, 0), (0, 0), (0, pad), (0, 0))
    kh = jnp.pad(k.transpose(0, 2, 1, 3), padw).reshape(B, H, nb, MOBA_BLOCK, Dh)
    vh = jnp.pad(v.transpose(0, 2, 1, 3), padw).reshape(B, H, nb, MOBA_BLOCK, Dh)
    own = (jnp.arange(S) // MOBA_BLOCK).astype(jnp.int32)
    own_b = jnp.broadcast_to(own[:, None], (B, H, S, 1))
    n_sel = min(MOBA_TOPK, nb - 1)
    if n_sel > 0:
        kmean = jnp.mean(kh.astype(jnp.float32), axis=3)
        gate = jnp.einsum('bhsd,bhnd->bhsn', qh.astype(jnp.float32), kmean)
        past = jnp.arange(nb)[None, :] < own[:, None]
        gate = jnp.where(past, gate, NEG)
        _, sel = lax.top_k(gate, n_sel)
        blocks = jnp.concatenate([sel.astype(jnp.int32), own_b], axis=-1)
        bvalid = jnp.concatenate([sel < own[:, None], jnp.ones((B, H, S, 1), bool)], axis=-1)
    else:
        blocks = own_b
        bvalid = jnp.ones((B, H, S, 1), bool)
    nq = S // MOBA_Q_BLOCK
    bi = jnp.arange(B)[:, None, None, None]
    hi = jnp.arange(H)[None, :, None, None]
    offs = jnp.arange(MOBA_BLOCK)

    def chunks(a):
        return jnp.moveaxis(a.reshape(B, H, nq, MOBA_Q_BLOCK, *a.shape[3:]), 2, 0)

    def block(args):
        qb, bl, bv, t = args
        kg = kh[bi, hi, bl]
        vg = vh[bi, hi, bl]
        s = jnp.einsum('bhqd,bhqnkd->bhqnk', qb, kg).astype(jnp.float32) * scale
        kpos = bl[..., None] * MOBA_BLOCK + offs
        mask = bv[..., None] & (kpos <= t[:, None, None])
        s = jnp.where(mask, s, NEG)
        shp = s.shape
        p = jax.nn.softmax(s.reshape(shp[0], shp[1], shp[2], -1), axis=-1).reshape(shp).astype(v.dtype)
        return jnp.einsum('bhqnk,bhqnkd->bhqd', p, vg)

    t_c = jnp.arange(S).reshape(nq, MOBA_Q_BLOCK)
    out = lax.map(block, (chunks(qh), chunks(blocks), chunks(bvalid), t_c))
    out = jnp.moveaxis(out, 0, 2).reshape(B, H, S, Dh)
    return out.transpose(0, 2, 1, 3).reshape(B, S, H * Dh)


def setup_inputs(seed: int = 0) -> dict:
    key = jax.random.key(seed)
    ks = jax.random.split(key, 16)
    f32 = jnp.float32

    def w(k, shape, fan_in):
        return jax.random.normal(k, shape, f32) * fan_in ** -0.5

    def gain(k, shape):
        return 1.0 + 0.02 * jax.random.normal(k, shape, f32)

    return {
        "x": jax.random.normal(ks[0], (BATCH, SEQ, D_MODEL), f32),
        "c": jax.random.normal(ks[1], (BATCH, D_MODEL), f32),
        "w_mod": w(ks[2], (DEPTH, D_MODEL, N_MOD * D_MODEL), D_MODEL),
        "b_mod": 0.02 * jax.random.normal(ks[3], (DEPTH, N_MOD * D_MODEL), f32),
        "g_mix_norm": gain(ks[4], (DEPTH, D_MODEL)),
        "g_ffn_norm": gain(ks[5], (DEPTH, D_MODEL)),
        "w_in": w(ks[6], (DEPTH, D_MODEL, IN_W), D_MODEL),
        "g_q_dsa": gain(ks[7], (DEPTH, HEAD_DIM)),
        "g_k_dsa": gain(ks[8], (DEPTH, HEAD_DIM)),
        "g_q_moba": gain(ks[9], (DEPTH, HEAD_DIM)),
        "g_k_moba": gain(ks[10], (DEPTH, HEAD_DIM)),
        "w_br_dsa": w(ks[11], (DEPTH, DSA_W, D_MODEL), DSA_W),
        "w_br_moba": w(ks[12], (DEPTH, MOBA_W, D_MODEL), MOBA_W),
        "w_out": w(ks[13], (DEPTH, D_MODEL, D_MODEL), D_MODEL),
        "w_gate_up": w(ks[14], (DEPTH, D_MODEL, 2 * D_FF), D_MODEL),
        "w_down": w(ks[15], (DEPTH, D_FF, D_MODEL), D_FF),
    }


def reference(x, c, w_mod, b_mod, g_mix_norm, g_ffn_norm, w_in, g_q_dsa, g_k_dsa,
              g_q_moba, g_k_moba, w_br_dsa, w_br_moba, w_out, w_gate_up, w_down):
    B, S, _ = x.shape
    cos_h, sin_h = rope_tables(S, HEAD_DIM)
    cos_i, sin_i = rope_tables(S, IDX_DIM)
    split_at = np.cumsum(IN_SIZES)[:-1].tolist()
    idx_w_scale = (IDX_HEADS ** -0.5) * (IDX_DIM ** -0.5)
    for l in range(DEPTH):
        mod = jax.nn.silu(c) @ w_mod[l] + b_mod[l]
        sh_m, sc_m, gt_m, sh_f, sc_f, gt_f = [m[:, None, :] for m in jnp.split(mod, N_MOD, axis=-1)]

        h = rms_norm(x, g_mix_norm[l]) * (1.0 + sc_m) + sh_m
        proj = h @ w_in[l]
        (q_a, k_a, v_a, q_i, k_i, w_i, q_b, k_b, v_b, gate_a, gate_b) = jnp.split(proj, split_at, axis=-1)
        q_a = apply_rope(rms_norm(q_a.reshape(B, S, DSA_HEADS, HEAD_DIM), g_q_dsa[l]), cos_h, sin_h)
        k_a = apply_rope(rms_norm(k_a.reshape(B, S, DSA_HEADS, HEAD_DIM), g_k_dsa[l]), cos_h, sin_h)
        v_a = v_a.reshape(B, S, DSA_HEADS, HEAD_DIM)
        q_i = apply_rope(q_i.reshape(B, S, IDX_HEADS, IDX_DIM), cos_i, sin_i)
        k_i = apply_rope(k_i[:, :, None, :], cos_i, sin_i)[:, :, 0, :]
        w_i = w_i * idx_w_scale
        o_a = dsa_attention(q_a, k_a, v_a, q_i, k_i, w_i)

        q_b = apply_rope(rms_norm(q_b.reshape(B, S, MOBA_HEADS, HEAD_DIM), g_q_moba[l]), cos_h, sin_h)
        k_b = apply_rope(rms_norm(k_b.reshape(B, S, MOBA_HEADS, HEAD_DIM), g_k_moba[l]), cos_h, sin_h)
        v_b = v_b.reshape(B, S, MOBA_HEADS, HEAD_DIM)
        o_b = moba_attention(q_b, k_b, v_b)

        merged = (jax.nn.sigmoid(gate_a) * (o_a @ w_br_dsa[l])
                  + jax.nn.sigmoid(gate_b) * (o_b @ w_br_moba[l]))
        x = x + gt_m * (merged @ w_out[l])

        h = rms_norm(x, g_ffn_norm[l]) * (1.0 + sc_f) + sh_f
        g_ff, u_ff = jnp.split(h @ w_gate_up[l], 2, axis=-1)
        x = x + gt_f * ((jax.nn.silu(g_ff) * u_ff) @ w_down[l])
    return x
```

```cpp
#include <hip/hip_runtime.h>
#include <cstdint>
#include <cstdio>
typedef _Float16 h16;
typedef unsigned long long u64;

constexpr int NB = 4, S_ = 4096, D_ = 1024, T_ = NB * S_, HD = 128, NH = 4, IH = 8, ID = 64, TOPK = 256, MBLK = 256, NBLK = 16;
constexpr int DFF = 2816, INW = 5704, HW = 512;
constexpr float EPS = 1e-6f;
constexpr int C_QA = 0, C_KA = 512, C_VA = 1024, C_QI = 1536, C_KI = 2048, C_WI = 2112, C_QB = 2120, C_KB = 2632, C_VB = 3144, C_GA = 3656, C_GB = 4680;
constexpr int NIN = 5888;
constexpr int NGU = 2 * DFF;

constexpr size_t KiB = 1024, MiB = 1u << 20;
constexpr size_t WS_CTL = 0, CTL_ZERO_BYTES = 64 * KiB;
constexpr size_t WS_MOD = 1 * MiB;
constexpr size_t WS_KMEAN = 1 * MiB + 256 * KiB;
constexpr size_t WS_M16 = 1 * MiB + 512 * KiB;
constexpr size_t WS_BIAS2 = 1 * MiB + 768 * KiB;
constexpr size_t WS_GAINS = 1 * MiB + 896 * KiB;
constexpr size_t WS_WI = 2 * MiB;
constexpr size_t WS_SSQ = 2 * MiB + 512 * KiB;
constexpr size_t WS_KI = 3 * MiB + 512 * KiB;
constexpr size_t WS_MASK = 5 * MiB + 512 * KiB;
constexpr size_t WS_COS128 = 13 * MiB + 512 * KiB, WS_SIN128 = WS_COS128 + MiB, WS_COS64 = WS_SIN128 + MiB, WS_SIN64 = WS_COS64 + 512 * KiB;
constexpr size_t WS_WIN = 16 * MiB + 512 * KiB;
constexpr size_t WS_WA = WS_WIN + (size_t)NIN * 1024 * 2, WS_WB = WS_WA + MiB, WS_WOUT = WS_WB + MiB;
constexpr size_t WS_WGU = WS_WOUT + 2 * MiB;
constexpr size_t WS_WDN = WS_WGU + (size_t)NGU * 1024 * 2;
constexpr size_t WS_HN = 48 * MiB + 512 * KiB;
constexpr size_t WS_MASKB = WS_HN;
constexpr size_t WS_QA = 80 * MiB + 512 * KiB, WS_KA = WS_QA + 16 * MiB, WS_VA = WS_KA + 16 * MiB, WS_KB = WS_VA + 16 * MiB, WS_VB = WS_KB + 16 * MiB;
constexpr size_t WS_QB = WS_VB + 16 * MiB, WS_QI = WS_QB + 16 * MiB, WS_QBL = WS_QI + 16 * MiB;
constexpr size_t WS_A2 = WS_QBL + 16 * MiB;
constexpr int X1H_SPLIT = 44;
constexpr size_t WS_X1HA = WS_MASK, WS_X1HB = WS_A2 + 32 * MiB;
static_assert(WS_X1HA + (size_t)X1H_SPLIT * 256 * 2048 <= WS_WA && WS_X1HB + (size_t)(64 - X1H_SPLIT) * 256 * 2048 <= 256 * MiB, "x1 pieces fit");
constexpr size_t WS_ACT = WS_QA;
static_assert(WS_WDN + (size_t)1024 * DFF * 2 <= WS_HN, "weights fit");
static_assert(WS_A2 + 32 * MiB <= 256 * MiB, "ws fits");

__device__ __forceinline__ float sigmoidf_(float v) { return 1.f / (1.f + __expf(-v)); }


#define LAS __attribute__((address_space(3)))
#define GAS __attribute__((address_space(1)))
typedef _Float16 f16x8 __attribute__((ext_vector_type(8)));
typedef _Float16 f16x4 __attribute__((ext_vector_type(4)));
typedef _Float16 f16x2 __attribute__((ext_vector_type(2)));
typedef float f32x4 __attribute__((ext_vector_type(4)));
typedef float f32x2 __attribute__((ext_vector_type(2)));
typedef unsigned u32x4 __attribute__((ext_vector_type(4)));
typedef unsigned u32x2 __attribute__((ext_vector_type(2)));

__device__ __forceinline__ unsigned pkh(float a, float b) { f16x2 v = {(h16)a, (h16)b}; return __builtin_bit_cast(unsigned, v); }
__device__ __forceinline__ u32x2 pkh4(f32x4 a) { u32x2 r; r.x = pkh(a[0], a[1]); r.y = pkh(a[2], a[3]); return r; }
__device__ __forceinline__ u32x4 pkh8(f32x4 a, f32x4 b) { u32x4 r; r.x = pkh(a[0], a[1]); r.y = pkh(a[2], a[3]); r.z = pkh(b[0], b[1]); r.w = pkh(b[2], b[3]); return r; }
__device__ __forceinline__ f32x4 unpk4(u32x2 w) { const f16x4 h = __builtin_bit_cast(f16x4, w); f32x4 r; r[0] = (float)h[0]; r[1] = (float)h[1]; r[2] = (float)h[2]; r[3] = (float)h[3]; return r; }
__device__ __forceinline__ void unpk8(u32x4 w, f32x4& lo, f32x4& hi) { const f16x8 h = __builtin_bit_cast(f16x8, w);
    lo[0] = (float)h[0]; lo[1] = (float)h[1]; lo[2] = (float)h[2]; lo[3] = (float)h[3]; hi[0] = (float)h[4]; hi[1] = (float)h[5]; hi[2] = (float)h[6]; hi[3] = (float)h[7]; }

namespace pg8 {
constexpr int BM = 256, BK = 64, HALF = 128, HTB = HALF * BK * 2  , STAGE_BYTES = 8 * HTB, NXCD = 8, WGM = 8;
__host__ __device__ __forceinline__ int lds_byte(int r, int c) { const int st = (r >> 4) * 2 + (c >> 5), rr = r & 15, cc = c & 31, ob = rr * 64 + cc * 2; return st * 1024 + (ob ^ (((ob >> 9) & 1) << 5)); }
__host__ __device__ __forceinline__ void stage_rc(int b, int& R, int& C) { const int st = b / 1024, sb = b % 1024, swz = sb ^ (((sb >> 9) & 1) << 5); R = (st >> 1) * 16 + swz / 64; C = (st & 1) * 32 + (swz % 64) / 2; }

struct Unit { int pm, pn, seg; };
struct Gemm { const h16* A0; const h16* A1; const h16* B0; const h16* B1; int K; };

struct StaticOrder {
    int nM, nN, nwg, G, c, nseg, cap;
    __device__ void init(int M, int N, int G_, int c_, int nseg_ = 1) { nM = M / BM; nN = N / BM; nwg = nM * nN; G = G_; c = c_; nseg = nseg_; cap = nwg; }
    __device__ void tile_of(int wgid_, Unit& u) const { int wgid = wgid_; { const int q = nwg / NXCD, r = nwg % NXCD, xcd = wgid % NXCD, off = wgid / NXCD; wgid = (xcd < r ? xcd * (q + 1) : r * (q + 1) + (xcd - r) * q) + off; }
        const int nig = WGM * nN, gid = wgid / nig, fm = gid * WGM, gsz = (nM - fm) < WGM ? (nM - fm) : WGM;
        u.pm = fm + ((wgid % nig) % gsz); u.pn = (wgid % nig) / gsz; }
    __device__ bool next(int i, Unit& u) const {
        const int it = i / nseg; u.seg = i % nseg;
        const long L = (long)it * G + c; if (L >= cap) return false;
        int wgid = (int)L; { const int q = nwg / NXCD, r = nwg % NXCD, xcd = wgid % NXCD, off = wgid / NXCD; wgid = (xcd < r ? xcd * (q + 1) : r * (q + 1) + (xcd - r) * q) + off; }
        const int nig = WGM * nN, gid = wgid / nig, fm = gid * WGM, gsz = (nM - fm) < WGM ? (nM - fm) : WGM;
        u.pm = fm + ((wgid % nig) % gsz); u.pn = (wgid % nig) / gsz; return true;
    }
};

struct HalfTail {
    StaticOrder S; int c;
    __device__ bool next(int i, Unit& u) const { if (i != 0) return false; S.tile_of(S.cap + 8 * (c >> 4) + (c & 7), u); u.seg = (c >> 3) & 1; return true; }
};

typedef f32x4 Acc[2][2][4][2];

template <class Epi, class Sched, bool HALFM = false>
__device__ __forceinline__ void gemm_phase(LAS unsigned char* lds, const Gemm g, const Sched& S, const Epi& E) {
    const int tid = threadIdx.x, wid = __builtin_amdgcn_readfirstlane(tid >> 6), lane = tid & 63, wr = wid >> 2, wc = wid & 3, fr = lane & 15, fq = lane >> 4;
    const int K = g.K, nt = K / BK;
    unsigned voffA[2];
#pragma unroll
    for (int i = 0; i < 2; ++i) { int R, C; stage_rc(tid * 16 + i * 8192, R, C); voffA[i] = (unsigned)(R * K + C) * 2u; }
    const size_t kstep = (size_t)(BK * 2);
    const size_t hstep = (size_t)HALF * K * 2;
    const size_t tstep = 2 * hstep;
    const unsigned ldsw = (unsigned)wid * 1024u;
    const int aoff = lds_byte(wr * 64 + fr, fq * 8), boff = lds_byte(wc * 32 + fr, fq * 8);
#define PG8_SA(b, h) (((b) * 2 + (h)) * HTB)
#define PG8_SB(b, h) ((4 + (b) * 2 + (h)) * HTB)
#define PG8_STAGE(bufoff, gbase) do { _Pragma("unroll") for (int _i = 0; _i < 2; ++_i) \
        __builtin_amdgcn_global_load_lds((const unsigned*)((const char*)(gbase) + voffA[_i]), (LAS unsigned*)(lds + (bufoff) + ldsw + _i * 8192), 16, 0, 0); } while (0)
#define PG8_LDA(dst, b, h) do { _Pragma("unroll") for (int m = 0; m < 4; ++m) _Pragma("unroll") for (int k = 0; k < 2; ++k) dst[m][k] = *(const LAS f16x8*)(lds + PG8_SA(b, h) + aoff + m * 2048 + k * 1024); } while (0)
#define PG8_LDB(dst, b, h) do { _Pragma("unroll") for (int n = 0; n < 2; ++n) _Pragma("unroll") for (int k = 0; k < 2; ++k) dst[n][k] = *(const LAS f16x8*)(lds + PG8_SB(b, h) + boff + n * 2048 + k * 1024); } while (0)
#define PG8_MMA(ai, bj, At, Bt) do { __builtin_amdgcn_s_setprio(1); _Pragma("unroll") for (int m = 0; m < 4; ++m) _Pragma("unroll") for (int n = 0; n < 2; ++n) _Pragma("unroll") for (int k = 0; k < 2; ++k) \
        acc[ai][bj][m][n] = __builtin_amdgcn_mfma_f32_16x16x32_f16(Bt[n][k], At[m][k], acc[ai][bj][m][n], 0, 0, 0); __builtin_amdgcn_s_setprio(0); } while (0)
#define PG8_WAIT_V(n) asm volatile("s_waitcnt vmcnt(" #n ")" ::: "memory")
#define PG8_WAIT_L(n) asm volatile("s_waitcnt lgkmcnt(" #n ")" ::: "memory")
#define PG8_BAR __builtin_amdgcn_s_barrier()
#define PG8_SCHED __builtin_amdgcn_sched_barrier(0)
#define PG8_ZERO() do { _Pragma("unroll") for (int a = 0; a < 2; ++a) _Pragma("unroll") for (int b = 0; b < 2; ++b) _Pragma("unroll") for (int m = 0; m < 4; ++m) _Pragma("unroll") for (int n = 0; n < 2; ++n) acc[a][b][m][n] = (f32x4){0.f, 0.f, 0.f, 0.f}; } while (0)
    Unit cur, nxt; int ui = 0;
    if (!S.next(0, cur)) return;
    Acc acc;
    PG8_ZERO();
    f16x8 At[4][2], B0[2][2], B1[2][2];
    const char* cA = (const char*)(cur.seg ? g.A1 : g.A0) + (size_t)cur.pm * tstep; const char* cB = (const char*)(cur.seg ? g.B1 : g.B0) + (size_t)cur.pn * tstep;
    PG8_STAGE(PG8_SB(0, 0), cB); PG8_STAGE(PG8_SB(0, 1), cB + hstep); PG8_STAGE(PG8_SA(0, 0), cA); if constexpr (!HALFM) PG8_STAGE(PG8_SA(0, 1), cA + hstep);
    if (wr == 1) PG8_BAR;
    if constexpr (HALFM) PG8_WAIT_V(0); else PG8_WAIT_V(2);
    PG8_BAR;
    PG8_STAGE(PG8_SB(1, 0), cB + kstep); PG8_STAGE(PG8_SA(1, 0), cA + kstep); PG8_STAGE(PG8_SB(1, 1), cB + hstep + kstep);
    PG8_WAIT_V(6); PG8_BAR;
    for (;;) {
        const bool has_next = S.next(ui + 1, nxt);
        const char* nA = has_next ? (const char*)(nxt.seg ? g.A1 : g.A0) + (size_t)nxt.pm * tstep : cA; const char* nB = has_next ? (const char*)(nxt.seg ? g.B1 : g.B0) + (size_t)nxt.pn * tstep : cB;
        for (int t = 0; t < nt; t += 2) {
            const bool last = (t == nt - 2);
            const char* a1 = cA + (size_t)(t + 1) * kstep;
            const char* a2 = last ? nA : cA + (size_t)(t + 2) * kstep; const char* b2 = last ? nB : cB + (size_t)(t + 2) * kstep;
            const char* a3 = a2 + kstep; const char* b3 = b2 + kstep;
            if constexpr (!HALFM) {
            PG8_LDB(B0, 0, 0); PG8_LDB(B1, 0, 1); PG8_SCHED; PG8_LDA(At, 0, 0); PG8_STAGE(PG8_SA(1, 1), a1 + hstep);
            PG8_WAIT_V(8); PG8_WAIT_L(0); PG8_BAR; PG8_MMA(0, 0, At, B0); PG8_MMA(0, 1, At, B1); PG8_BAR; PG8_SCHED;
            PG8_LDA(At, 0, 1); PG8_STAGE(PG8_SB(0, 0), b2); PG8_STAGE(PG8_SB(0, 1), b2 + hstep); PG8_STAGE(PG8_SA(0, 0), a2);
            PG8_WAIT_V(8); PG8_WAIT_L(0); PG8_BAR; PG8_MMA(1, 0, At, B0); PG8_MMA(1, 1, At, B1); PG8_BAR; PG8_SCHED;
            PG8_LDB(B0, 1, 0); PG8_LDB(B1, 1, 1); PG8_SCHED; PG8_LDA(At, 1, 0); PG8_STAGE(PG8_SA(0, 1), a2 + hstep);
            PG8_WAIT_V(8); PG8_WAIT_L(0); PG8_BAR; PG8_MMA(0, 0, At, B0); PG8_MMA(0, 1, At, B1); PG8_BAR; PG8_SCHED;
            PG8_LDA(At, 1, 1); PG8_STAGE(PG8_SB(1, 0), b3); PG8_STAGE(PG8_SB(1, 1), b3 + hstep); PG8_STAGE(PG8_SA(1, 0), a3);
            PG8_WAIT_V(8); PG8_WAIT_L(0); PG8_BAR; PG8_MMA(1, 0, At, B0); PG8_MMA(1, 1, At, B1); PG8_BAR; PG8_SCHED;
            } else {
            (void)a1;
            PG8_LDB(B0, 0, 0); PG8_LDB(B1, 0, 1); PG8_SCHED; PG8_LDA(At, 0, 0);
            PG8_WAIT_L(0); PG8_BAR; PG8_MMA(0, 0, At, B0); PG8_MMA(0, 1, At, B1); PG8_BAR; PG8_SCHED;
            PG8_STAGE(PG8_SB(0, 0), b2); PG8_STAGE(PG8_SB(0, 1), b2 + hstep); PG8_STAGE(PG8_SA(0, 0), a2);
            PG8_WAIT_V(6); PG8_BAR; PG8_BAR; PG8_SCHED;
            PG8_LDB(B0, 1, 0); PG8_LDB(B1, 1, 1); PG8_SCHED; PG8_LDA(At, 1, 0);
            PG8_WAIT_L(0); PG8_BAR; PG8_MMA(0, 0, At, B0); PG8_MMA(0, 1, At, B1); PG8_BAR; PG8_SCHED;
            PG8_STAGE(PG8_SB(1, 0), b3); PG8_STAGE(PG8_SB(1, 1), b3 + hstep); PG8_STAGE(PG8_SA(1, 0), a3);
            PG8_WAIT_V(6); PG8_BAR; PG8_BAR; PG8_SCHED;
            }
        }
        if (wr == 0) PG8_BAR;
        int fr_ = fr, fq_ = fq; asm volatile("" : "+v"(fr_), "+v"(fq_));
        const bool zero = E(acc, cur, nxt, has_next, ui, wr, wc, fr_, fq_, wid, fq_ * 16 + fr_, lds + STAGE_BYTES);
        if (!has_next) break;
        if (zero) PG8_ZERO();
        cur = nxt; cA = nA; cB = nB; ++ui;
        if (wr == 1) PG8_BAR;
    }
    PG8_WAIT_V(0);
    PG8_BAR;
#undef PG8_SA
#undef PG8_SB
#undef PG8_STAGE
#undef PG8_LDA
#undef PG8_LDB
#undef PG8_MMA
#undef PG8_ZERO
}
#define EPI_LWAIT_BAR() do { asm volatile("s_waitcnt lgkmcnt(0)" ::: "memory"); __builtin_amdgcn_s_barrier(); asm volatile("" ::: "memory"); } while (0)
}

constexpr int NWAVES = 8;
constexpr int RING_BYTES = 131072, SCR_OFF = RING_BYTES, LDS_BYTES = 155648, MISC_OFF = LDS_BYTES - 256;
constexpr int SCR_P = 0, SCR_KS = 4096, SCR_R = 6144, SCR_DT128 = 8192, SCR_DT64 = 12288;

typedef GAS unsigned gu32;
#define RLX_AGENT __ATOMIC_RELAXED, __HIP_MEMORY_SCOPE_AGENT
#define LDS_WAIT() asm volatile("s_waitcnt lgkmcnt(0)" ::: "memory")
#define VM_WAIT() asm volatile("s_waitcnt vmcnt(0)" ::: "memory")

#define XB_TMO      128
#define XB_XCNT(j)  (256  + 64 * (j))
#define XB_XSUB(j)  (1280 + 64 * (j))
#define XB_XGEN(j)  (2304 + 64 * (j))
#define XB_TOP      3328
#define XB_TOPGEN   3392
#define XCD_BAR_WORDS 3456
#define XB_CLS(k)  (129 + (k))
#define XB_MIS     140
#define XB_LSUB(j) (256 + 64 * (j) + 16)
#define XB_P5D     141
#define XB_SPIN_CAP (1u << 20)
__device__ __forceinline__ unsigned xb_ld(unsigned* p)              { return __hip_atomic_load(p, __ATOMIC_RELAXED, __HIP_MEMORY_SCOPE_AGENT); }
__device__ __forceinline__ unsigned xb_add(unsigned* p, unsigned v) { return __hip_atomic_fetch_add(p, v, __ATOMIC_RELAXED, __HIP_MEMORY_SCOPE_AGENT); }
__device__ __forceinline__ unsigned xb_xcc_id() { return (unsigned)__builtin_amdgcn_s_getreg((3 << 11) | 20) & 0xFu; }
#define XB_SPIN(cond, bar) do { unsigned _sp = 0; while (cond) { __builtin_amdgcn_s_sleep(1); \
    if ((++_sp & 255u) == 0u) { if (xb_ld(&(bar)[XB_TMO])) break; if (_sp > XB_SPIN_CAP) { atomicAdd(&(bar)[XB_TMO], 1u); break; } } } } while (0)
struct XcdBarrier { unsigned* bar; unsigned x; volatile LAS unsigned* st; };
__device__ __forceinline__ XcdBarrier xcd_barrier_post(unsigned* bar, volatile LAS unsigned* st) {
    XcdBarrier b; b.bar = bar; b.x = xb_xcc_id(); b.st = st;
    if (threadIdx.x == 0) { (void)xb_add(&bar[XB_XCNT(b.x)], 1u);
        unsigned seen = 0u; const unsigned want = b.x + 1u;
        if (!__hip_atomic_compare_exchange_strong(&bar[XB_CLS(blockIdx.x & 7u)], &seen, want, __ATOMIC_RELAXED, __ATOMIC_RELAXED, __HIP_MEMORY_SCOPE_AGENT) && seen != want) (void)xb_add(&bar[XB_MIS], 1u); }
    return b;
}
__device__ __forceinline__ void xcd_barrier_complete(unsigned* bar, unsigned x, unsigned& nloc, unsigned& nx) {
    const unsigned G = gridDim.x * gridDim.y * gridDim.z;
    unsigned sum, cnt, mine, sp = 0u;
    for (;;) {
        sum = 0u; cnt = 0u; mine = 0u;
#pragma unroll
        for (unsigned j = 0; j < 16; ++j) { const unsigned c = xb_ld(&bar[XB_XCNT(j)]); sum += c; cnt += (c > 0u) ? 1u : 0u; mine = (j == x) ? c : mine; }
        if (sum == G) break;
        __builtin_amdgcn_s_sleep(1);
        if ((++sp & 255u) == 0u) { if (xb_ld(&bar[XB_TMO])) break; if (sp > XB_SPIN_CAP) { atomicAdd(&bar[XB_TMO], 1u); break; } }
    }
    nloc = mine > 0u ? mine : 1u; nx = cnt > 0u ? cnt : 1u;
}
__device__ __forceinline__ void xcd_barrier(const XcdBarrier& b) {
    asm volatile("s_waitcnt vmcnt(0)" ::: "memory");
    __syncthreads();
    if (threadIdx.x == 0) {
        unsigned* bar = b.bar;
        __builtin_amdgcn_s_waitcnt(0);
        unsigned nloc = b.st[0], nx = b.st[1];
        if (nloc == 0u) { xcd_barrier_complete(bar, b.x, nloc, nx); b.st[0] = nloc; b.st[1] = nx; }
        const unsigned old = xb_add(&bar[XB_XSUB(b.x)], 1u);
        const unsigned gen = old / nloc;
        if (old + 1u == (gen + 1u) * nloc) {
            __builtin_amdgcn_fence(__ATOMIC_RELEASE, "agent");
            asm volatile("s_waitcnt vmcnt(0)" ::: "memory");
            const unsigned og = xb_add(&bar[XB_TOP], 1u);
            const unsigned tg = og / nx;
            if (og + 1u == (tg + 1u) * nx) xb_add(&bar[XB_TOPGEN], 1u);
            else XB_SPIN(xb_ld(&bar[XB_TOPGEN]) == tg, bar);
            __builtin_amdgcn_fence(__ATOMIC_ACQUIRE, "agent");
            xb_add(&bar[XB_XGEN(b.x)], 1u);
            asm volatile("s_waitcnt vmcnt(0)" ::: "memory");
        } else {
            XB_SPIN(xb_ld(&bar[XB_XGEN(b.x)]) == gen, bar);
            __builtin_amdgcn_fence(__ATOMIC_ACQUIRE, "agent");
            asm volatile("s_waitcnt vmcnt(0)" ::: "memory");
        }
    }
    __syncthreads();
}

__device__ __forceinline__ void xcd_local_barrier(const XcdBarrier& b) {
    asm volatile("s_waitcnt vmcnt(0)" ::: "memory");
    __syncthreads();
    if (threadIdx.x == 0) {
        unsigned* bar = b.bar;
        __builtin_amdgcn_s_waitcnt(0);
        const unsigned nloc = b.st[0];
        const unsigned old = xb_add(&bar[XB_LSUB(b.x)], 1u);
        const unsigned tgt = (old / nloc + 1u) * nloc;
        XB_SPIN(xb_ld(&bar[XB_LSUB(b.x)]) < tgt, bar);
        __builtin_amdgcn_fence(__ATOMIC_ACQUIRE, "agent");
        asm volatile("s_waitcnt vmcnt(0)" ::: "memory");
    }
    __syncthreads();
}

struct Args {
    const float *x, *c, *w_mod, *b_mod, *g_mix, *g_ffn, *w_in, *g_q_dsa, *g_k_dsa, *g_q_moba, *g_k_moba, *w_br_dsa, *w_br_moba, *w_out, *w_gate_up, *w_down;
    float* out; unsigned char* ws; int ph_lo, ph_hi, li, flags;
};

__device__ __forceinline__ float wave_sum(float v) {
#pragma unroll
    for (int o = 1; o < 64; o <<= 1) v += __shfl_xor(v, o);
    return v;
}

__device__ __forceinline__ int lc_plain8(int x) { const int bj = x >> 7, wc = (x >> 5) & 3, n = (x >> 4) & 1, fq = (x >> 2) & 3, j = x & 3; return 128 * bj + 32 * wc + 8 * fq + 4 * n + j; }
__device__ __forceinline__ int lc_rope128(int x) { const int bj = x >> 7, wc = (x >> 5) & 3, n = (x >> 4) & 1, fq = (x >> 2) & 3, j = x & 3; return 128 * (wc >> 1) + 64 * bj + 32 * (wc & 1) + 8 * fq + 4 * n + j; }
__device__ __forceinline__ int lc_rope64(int x) { const int bj = x >> 7, wc = (x >> 5) & 3, n = (x >> 4) & 1, fq = (x >> 2) & 3, j = x & 3; return 64 * wc + 32 * bj + 8 * fq + 4 * n + j; }
__device__ __forceinline__ int in_tile_type(int pn) { return pn == 22 ? 3 : (pn == 6 || pn == 7) ? 2 : ((pn >= 4 && pn <= 5) || pn >= 12) ? 1 : 0; }
__device__ __forceinline__ int in_tile_src(int pn) {
    return pn < 2 ? C_QA + 256 * pn : pn < 4 ? C_KA + 256 * (pn - 2) : pn < 6 ? C_VA + 256 * (pn - 4) : pn < 8 ? C_QI + 256 * (pn - 6) : pn < 10 ? C_QB + 256 * (pn - 8)
         : pn < 12 ? C_KB + 256 * (pn - 10) : pn < 14 ? C_VB + 256 * (pn - 12) : pn < 18 ? C_GA + 256 * (pn - 14) : C_GB + 256 * (pn - 18);
}
struct MapIn { __device__ __forceinline__ int operator()(int cp) const { const int pn = cp >> 8, x = cp & 255, ty = in_tile_type(pn);
    if (ty == 3) { const int bj = x >> 7, wc = (x >> 5) & 3, n = (x >> 4) & 1, fq = (x >> 2) & 3, j = x & 3; if (wc == 0) return C_KI + 32 * bj + 8 * fq + 4 * n + j; if (wc == 1 && bj == 0 && fq == 0) return C_WI + 4 * n + j; return -1; }
    return in_tile_src(pn) + (ty == 0 ? lc_rope128(x) : ty == 1 ? lc_plain8(x) : lc_rope64(x)); } };
struct MapPlain { __device__ __forceinline__ int operator()(int cp) const { return (cp & ~255) + lc_plain8(cp & 255); } };
struct MapGU { __device__ __forceinline__ int operator()(int cp) const { const int pn = cp >> 8, x = cp & 255, bj = x >> 7, wc = (x >> 5) & 3, n = (x >> 4) & 1, fq = (x >> 2) & 3, j = x & 3;
    return n * DFF + 128 * pn + 64 * bj + 16 * wc + 4 * fq + j; } };

template <class Map>
__device__ __forceinline__ void cvt_item(const float* W, int ldw, int K, h16* WT, int ngrp, int item, Map map, LAS float* scr, int lane) {
    const int kb = item / ngrp, grp = item % ngrp, k0 = 64 * kb, c0 = 32 * grp;
    const int src = map(c0 + (lane & 31));
    float v[32];
    const float* wp = W + (size_t)(k0 + (lane >> 5)) * ldw + (src >= 0 ? src : 0);
#pragma unroll
    for (int i = 0; i < 32; ++i) v[i] = wp[(size_t)(2 * i) * ldw];
#pragma unroll
    for (int i = 0; i < 32; ++i) scr[(2 * i + (lane >> 5)) * 33 + (lane & 31)] = src >= 0 ? v[i] : 0.f;
    LDS_WAIT(); asm volatile("" ::: "memory");
    const int c = lane & 7;
#pragma unroll
    for (int j = 0; j < 4; ++j) { const int n = (lane >> 3) + 8 * j; const LAS float* s = scr + (8 * c) * 33 + n;
        u32x4 o; o.x = pkh(s[0 * 33], s[1 * 33]); o.y = pkh(s[2 * 33], s[3 * 33]); o.z = pkh(s[4 * 33], s[5 * 33]); o.w = pkh(s[6 * 33], s[7 * 33]);
        *(GAS u32x4*)(WT + (size_t)(c0 + n) * K + k0 + 8 * c) = o; }
    LDS_WAIT(); asm volatile("" ::: "memory");
}

__device__ __forceinline__ void p0_prologue(const Args& a, LAS unsigned char* lds, int vcu, int G, int tid, int lane, int wave) {
    unsigned char* ws = a.ws;
    { LAS float* sc = (LAS float*)lds; LAS float* part = (LAS float*)(lds + 16384); float* MOD = (float*)(ws + WS_MOD);
      for (int m = vcu; m < 96; m += G) {
        for (int i = tid; i < 4096; i += 512) { const float v = a.c[i]; sc[i] = v / (1.f + expf(-v)); }
        __syncthreads();
        const int col = 64 * m + lane; float a0 = 0.f, a1 = 0.f, a2 = 0.f, a3 = 0.f;
#pragma unroll 1
        for (int k0 = 128 * wave; k0 < 128 * wave + 128; k0 += 32) { float wv[32];
#pragma unroll
            for (int j = 0; j < 32; ++j) wv[j] = a.w_mod[(size_t)(k0 + j) * 6144 + col];
#pragma unroll
            for (int j = 0; j < 32; ++j) { const float w = wv[j]; a0 += sc[k0 + j] * w; a1 += sc[1024 + k0 + j] * w; a2 += sc[2048 + k0 + j] * w; a3 += sc[3072 + k0 + j] * w; } }
        part[(wave * 4 + 0) * 64 + lane] = a0; part[(wave * 4 + 1) * 64 + lane] = a1; part[(wave * 4 + 2) * 64 + lane] = a2; part[(wave * 4 + 3) * 64 + lane] = a3;
        __syncthreads();
        if (tid < 256) { const int b = tid >> 6, cc = tid & 63; float s = 0.f;
#pragma unroll
            for (int w = 0; w < 8; ++w) s += part[(w * 4 + b) * 64 + cc];
            MOD[b * 6144 + 64 * m + cc] = s + a.b_mod[64 * m + cc]; }
        __syncthreads();
      } }
    if (vcu == 0) { float* GN = (float*)(ws + WS_GAINS);
        if (tid < 128) GN[tid] = a.g_q_dsa[tid]; else if (tid < 256) GN[tid] = a.g_k_dsa[tid - 128]; else if (tid < 384) GN[tid] = a.g_q_moba[tid - 256]; else GN[tid] = a.g_k_moba[tid - 384]; }
    { LAS float* scr = (LAS float*)(lds + 32768 + wave * 8448);
      const bool split = G >= 192; const int gw = (split ? vcu - 96 : vcu) * NWAVES + wave, NGW = (split ? G - 96 : G) * NWAVES;
      constexpr int I_IN = 16 * (NIN / 32);
      if (gw >= 0) for (int it = gw; it < I_IN; it += NGW) cvt_item(a.w_in, INW, 1024, (h16*)(ws + WS_WIN), NIN / 32, it, MapIn{}, scr, lane);
      }
    { float* C128 = (float*)(ws + WS_COS128); float* S128 = (float*)(ws + WS_SIN128); float* C64 = (float*)(ws + WS_COS64); float* S64 = (float*)(ws + WS_SIN64);
      const int gt = vcu * 512 + tid, NGT = G * 512;
      { const int i = gt & 63; const float inv = (float)pow(10000.0, -(double)(2 * i) / 128.0);
        for (int e = gt; e < S_ * 64; e += NGT) { const int t = e >> 6; float sn, cs; sincosf((float)t * inv, &sn, &cs); C128[e] = cs; S128[e] = sn; } }
      { const int i = gt & 31; const float inv = (float)pow(10000.0, -(double)(2 * i) / 64.0);
        for (int e = gt; e < S_ * 32; e += NGT) { const int t = e >> 5; float sn, cs; sincosf((float)t * inv, &sn, &cs); C64[e] = cs; S64[e] = sn; } } }
}

__device__ __forceinline__ void p1_hn(const Args& a, int vcu, int G, int lane, int wave) {
    unsigned char* ws = a.ws; const float* MOD = (const float*)(ws + WS_MOD); h16* HN = (h16*)(ws + WS_HN);
    const int gw = vcu * NWAVES + wave, NGW = G * NWAVES;
    if (T_ % NGW != 0 || S_ % (T_ / NGW) != 0) {
        for (int row = gw; row < T_; row += NGW) { const int b = row >> 12; const GAS f32x4* xr = (const GAS f32x4*)(a.x + (size_t)row * D_) + lane; f32x4 v[4]; float t = 0.f;
#pragma unroll
            for (int j = 0; j < 4; ++j) { v[j] = xr[64 * j]; t += (v[j].x * v[j].x + v[j].y * v[j].y) + (v[j].z * v[j].z + v[j].w * v[j].w); }
            const float r = rsqrtf(wave_sum(t) * (1.f / D_) + EPS); GAS u32x2* o = (GAS u32x2*)(HN + (size_t)row * D_) + lane;
#pragma unroll
            for (int j = 0; j < 4; ++j) { const int k = 4 * lane + 256 * j; o[64 * j] = pkh4(v[j] * r * *(const f32x4*)(a.g_mix + k) * (*(const f32x4*)(MOD + b * 6144 + 1024 + k) + 1.f) + *(const f32x4*)(MOD + b * 6144 + k)); } }
    } else
    { const int rpw = T_ / NGW;
      const int rbase = gw * rpw, b = rbase >> 12;
      f32x4 gs[4], shv[4];
#pragma unroll
      for (int j = 0; j < 4; ++j) { const int k = 4 * lane + 256 * j; gs[j] = *(const f32x4*)(a.g_mix + k) * (*(const f32x4*)(MOD + b * 6144 + 1024 + k) + 1.f); shv[j] = *(const f32x4*)(MOD + b * 6144 + k); }
      for (int r0 = 0; r0 < rpw; r0 += 4) {
        f32x4 v[4][4]; float ss[4];
#pragma unroll
        for (int q = 0; q < 4; ++q) { const int row = rbase + (r0 + q < rpw ? r0 + q : rpw - 1); const GAS f32x4* xr = (const GAS f32x4*)(a.x + (size_t)row * D_) + lane;
#pragma unroll
            for (int j = 0; j < 4; ++j) v[q][j] = xr[64 * j]; }
#pragma unroll
        for (int q = 0; q < 4; ++q) { float t = 0.f;
#pragma unroll
            for (int j = 0; j < 4; ++j) t += (v[q][j].x * v[q][j].x + v[q][j].y * v[q][j].y) + (v[q][j].z * v[q][j].z + v[q][j].w * v[q][j].w);
            ss[q] = t; }
#pragma unroll
        for (int o = 1; o < 64; o <<= 1) {
#pragma unroll
            for (int q = 0; q < 4; ++q) ss[q] += __shfl_xor(ss[q], o); }
#pragma unroll
        for (int q = 0; q < 4; ++q) if (r0 + q < rpw) { const float r = rsqrtf(ss[q] * (1.f / D_) + EPS); GAS u32x2* o = (GAS u32x2*)(HN + (size_t)(rbase + r0 + q) * D_) + lane;
#pragma unroll
            for (int j = 0; j < 4; ++j) o[64 * j] = pkh4(v[q][j] * r * gs[j] + shv[j]); }
      } }
}
__device__ __forceinline__ void p5_bias2(const Args& a, int vcu, int G, int lane, int wave) {
    unsigned char* ws = a.ws; const float* MOD = (const float*)(ws + WS_MOD);
    const int gw = vcu * NWAVES + wave, NGW = G * NWAVES;
    const h16* WGU = (const h16*)(ws + WS_WGU); float* BIAS2 = (float*)(ws + WS_BIAS2);
    for (int cp = gw; cp < NGU; cp += NGW) {
        const h16* wrow = WGU + (size_t)cp * 1024 + lane * 16;
        float d0 = 0.f, d1 = 0.f, d2 = 0.f, d3 = 0.f;
#pragma unroll
        for (int e = 0; e < 16; ++e) { const float w = (float)wrow[e]; const float* sh = MOD + 3072 + lane * 16 + e;
            d0 += w * sh[0]; d1 += w * sh[6144]; d2 += w * sh[2 * 6144]; d3 += w * sh[3 * 6144]; }
        d0 = wave_sum(d0); d1 = wave_sum(d1); d2 = wave_sum(d2); d3 = wave_sum(d3);
        if (lane == 0) { BIAS2[cp] = d0; BIAS2[NGU + cp] = d1; BIAS2[2 * NGU + cp] = d2; BIAS2[3 * NGU + cp] = d3; }
    }
}

__device__ __forceinline__ void rot8(const f32x4 (&c0)[2], const f32x4 (&s0)[2], const LAS float* dc, const LAS float* ds, f32x4 (&cs)[2], f32x4 (&sn)[2]) {
#pragma unroll
    for (int n = 0; n < 2; ++n) { const f32x4 cd = *(const LAS f32x4*)(dc + 4 * n), sd = *(const LAS f32x4*)(ds + 4 * n); cs[n] = c0[n] * cd - s0[n] * sd; sn[n] = s0[n] * cd + c0[n] * sd; }
}
struct EpiInProj {
    int noepi; unsigned char* ws; h16* GA;
    __device__ __forceinline__ bool operator()(pg8::Acc& acc, const pg8::Unit& u, const pg8::Unit& nxt, bool has_next, int ui, int wr, int wc, int fr, int fq, int wid, int lane, LAS unsigned char* scr) const {
        if (noepi) return true;
        const int pn = u.pn, ty = in_tile_type(pn), row0 = u.pm * 256 + wr * 64 + fr;
        if (ty == 1) {
            h16* dst; int ld, cb; bool sig = false;
            if (pn < 6) { dst = (h16*)(ws + WS_VA); ld = 512; cb = 256 * (pn - 4); } else if (pn < 14) { dst = (h16*)(ws + WS_VB); ld = 512; cb = 256 * (pn - 12); }
            else if (pn < 18) { dst = GA; ld = 1024; cb = 256 * (pn - 14); sig = true; } else { dst = GA + (size_t)T_ * 1024; ld = 1024; cb = 256 * (pn - 18); sig = true; }
#pragma unroll
            for (int ai = 0; ai < 2; ++ai)
#pragma unroll
                for (int m = 0; m < 4; ++m) { h16* rp = dst + (size_t)(row0 + ai * 128 + m * 16) * ld + cb + 32 * wc + 8 * fq;
#pragma unroll
                    for (int bj = 0; bj < 2; ++bj) { f32x4 v0 = acc[ai][bj][m][0], v1 = acc[ai][bj][m][1];
                        if (sig) {
#pragma unroll
                            for (int j = 0; j < 4; ++j) { v0[j] = fmaxf(sigmoidf_(v0[j]), 6.2e-5f); v1[j] = fmaxf(sigmoidf_(v1[j]), 6.2e-5f); } }
                        *(u32x4*)(rp + 128 * bj) = pkh8(v0, v1); } }
            return true;
        }
        const int t0 = row0 & (S_ - 1);
        if (ty == 0) {
            LAS float* P = (LAS float*)(scr + SCR_P);
            const int hl = wc >> 1, d0 = 32 * (wc & 1) + 8 * fq;
            const float* gain = (const float*)(ws + WS_GAINS) + 128 * (pn < 2 ? 0 : pn < 4 ? 1 : pn < 10 ? 2 : 3);
            f32x4 g1[2], g2[2], c0[2], s0[2];
#pragma unroll
            for (int n = 0; n < 2; ++n) { g1[n] = *(const f32x4*)(gain + d0 + 4 * n); g2[n] = *(const f32x4*)(gain + 64 + d0 + 4 * n);
                c0[n] = *(const f32x4*)((const float*)(ws + WS_COS128) + t0 * 64 + d0 + 4 * n); s0[n] = *(const f32x4*)((const float*)(ws + WS_SIN128) + t0 * 64 + d0 + 4 * n); }
#pragma unroll
            for (int ai = 0; ai < 2; ++ai)
#pragma unroll
                for (int m = 0; m < 4; ++m) { float s = 0.f;
#pragma unroll
                    for (int bj = 0; bj < 2; ++bj)
#pragma unroll
                        for (int n = 0; n < 2; ++n) { const f32x4 x = acc[ai][bj][m][n]; s += (x[0] * x[0] + x[1] * x[1]) + (x[2] * x[2] + x[3] * x[3]); }
                    s += __shfl_xor(s, 16); s += __shfl_xor(s, 32);
                    if (fq == 0) P[((ai * 128 + wr * 64 + m * 16 + fr) * 2 + hl) * 2 + (wc & 1)] = s; }
            EPI_LWAIT_BAR();
            h16* dst = (h16*)(ws + (pn < 2 ? WS_QA : pn < 4 ? WS_KA : pn < 10 ? WS_QB : WS_KB));
            h16* dlo = (h16*)(ws + WS_QBL); const bool has_lo = (pn == 8 || pn == 9), has_km = (pn >= 10);
            const int hb = 256 * (pn & 1) + 128 * hl + d0;
            const LAS float* DTc = (const LAS float*)(scr + SCR_DT128), * DTs = DTc + 512;
            f32x4 ks1[2] = {{0.f, 0.f, 0.f, 0.f}, {0.f, 0.f, 0.f, 0.f}}, ks2[2] = {{0.f, 0.f, 0.f, 0.f}, {0.f, 0.f, 0.f, 0.f}};
#pragma unroll
            for (int ai = 0; ai < 2; ++ai)
#pragma unroll
                for (int m = 0; m < 4; ++m) { const int rowl = ai * 128 + wr * 64 + m * 16 + fr, row = u.pm * 256 + rowl, ci = ai * 4 + m;
                    f32x4 cs[2], sn[2]; rot8(c0, s0, DTc + ci * 64 + d0, DTs + ci * 64 + d0, cs, sn);
                    const f32x2 p2 = *(const LAS f32x2*)(P + (rowl * 2 + hl) * 2);
                    const float r = rsqrtf((p2[0] + p2[1]) * (1.f / 128.f) + EPS);
                    f32x4 o1[2], o2[2];
#pragma unroll
                    for (int n = 0; n < 2; ++n) { const f32x4 x1 = acc[ai][0][m][n] * r * g1[n], x2 = acc[ai][1][m][n] * r * g2[n]; o1[n] = x1 * cs[n] - x2 * sn[n]; o2[n] = x2 * cs[n] + x1 * sn[n]; }
                    const u32x4 h1 = pkh8(o1[0], o1[1]), h2 = pkh8(o2[0], o2[1]);
                    h16* rp = dst + (size_t)row * 512 + hb; *(u32x4*)rp = h1; *(u32x4*)(rp + 64) = h2;
                    if (has_lo) { f32x4 a0, a1, b0, b1; unpk8(h1, a0, a1); unpk8(h2, b0, b1); h16* lp = dlo + (size_t)row * 512 + hb;
                        *(u32x4*)lp = pkh8(o1[0] - a0, o1[1] - a1); *(u32x4*)(lp + 64) = pkh8(o2[0] - b0, o2[1] - b1); }
                    if (has_km) { ks1[0] += o1[0]; ks1[1] += o1[1]; ks2[0] += o2[0]; ks2[1] += o2[1]; } }
            if (has_km) {
                LAS float* KS = (LAS float*)(scr + SCR_KS);
#pragma unroll
                for (int n = 0; n < 2; ++n)
#pragma unroll
                    for (int j = 0; j < 4; ++j) { float v1 = ks1[n][j], v2 = ks2[n][j];
#pragma unroll
                        for (int o = 1; o < 16; o <<= 1) { v1 += __shfl_xor(v1, o); v2 += __shfl_xor(v2, o); }
                        if (fr == 0) { KS[(wr * 2 + hl) * 128 + d0 + 4 * n + j] = v1; KS[(wr * 2 + hl) * 128 + 64 + d0 + 4 * n + j] = v2; } }
                EPI_LWAIT_BAR();
                const int tid = wid * 64 + lane;
                if (tid < 256) { const int h2 = tid >> 7, dd = tid & 127; const float v = (KS[(0 * 2 + h2) * 128 + dd] + KS[(1 * 2 + h2) * 128 + dd]) * (1.f / 256.f);
                    const int b = u.pm >> 4, blk = u.pm & 15, h = 2 * (pn & 1) + h2;
                    ((float*)(ws + WS_KMEAN))[((size_t)(b * NH + h) * NBLK + blk) * HD + dd] = v; }
            }
            return true;
        }
        const LAS float* DTc = (const LAS float*)(scr + SCR_DT64), * DTs = DTc + 256;
        const int e0 = 8 * fq;
        if (ty == 2 || wc == 0) {
            f32x4 c0[2], s0[2];
#pragma unroll
            for (int n = 0; n < 2; ++n) { c0[n] = *(const f32x4*)((const float*)(ws + WS_COS64) + t0 * 32 + e0 + 4 * n); s0[n] = *(const f32x4*)((const float*)(ws + WS_SIN64) + t0 * 32 + e0 + 4 * n); }
            h16* dst = ty == 2 ? (h16*)(ws + WS_QI) + 64 * (4 * (pn - 6) + wc) + e0 : (h16*)(ws + WS_KI) + e0; const int ld = ty == 2 ? 512 : 64;
#pragma unroll
            for (int ai = 0; ai < 2; ++ai)
#pragma unroll
                for (int m = 0; m < 4; ++m) { const int row = row0 + ai * 128 + m * 16, ci = ai * 4 + m;
                    f32x4 cs[2], sn[2]; rot8(c0, s0, DTc + ci * 32 + e0, DTs + ci * 32 + e0, cs, sn);
                    f32x4 o1[2], o2[2];
#pragma unroll
                    for (int n = 0; n < 2; ++n) { const f32x4 x1 = acc[ai][0][m][n], x2 = acc[ai][1][m][n]; o1[n] = x1 * cs[n] - x2 * sn[n]; o2[n] = x2 * cs[n] + x1 * sn[n]; }
                    h16* rp = dst + (size_t)row * ld; *(u32x4*)rp = pkh8(o1[0], o1[1]); *(u32x4*)(rp + 32) = pkh8(o2[0], o2[1]); }
        } else if (wc == 1 && fq == 0) { float* dst = (float*)(ws + WS_WI); const float scale = 0.35355339059327373f * 0.125f;
#pragma unroll
            for (int ai = 0; ai < 2; ++ai)
#pragma unroll
                for (int m = 0; m < 4; ++m) { const int row = row0 + ai * 128 + m * 16; *(f32x4*)(dst + (size_t)row * 8) = acc[ai][0][m][0] * scale; *(f32x4*)(dst + (size_t)row * 8 + 4) = acc[ai][0][m][1] * scale; } }
        return true;
    }
};
__device__ __forceinline__ void fill_rope_deltas(const unsigned char* ws, LAS unsigned char* scr, int tid) {
    LAS float* D128 = (LAS float*)(scr + SCR_DT128); LAS float* D64 = (LAS float*)(scr + SCR_DT64);
    { const int ci = tid >> 6, i = tid & 63, dl = 128 * (ci >> 2) + 16 * (ci & 3); D128[tid] = ((const float*)(ws + WS_COS128))[dl * 64 + i]; D128[512 + tid] = ((const float*)(ws + WS_SIN128))[dl * 64 + i]; }
    if (tid < 256) { const int ci = tid >> 5, i = tid & 31, dl = 128 * (ci >> 2) + 16 * (ci & 3); D64[tid] = ((const float*)(ws + WS_COS64))[dl * 32 + i]; D64[256 + tid] = ((const float*)(ws + WS_SIN64))[dl * 32 + i]; }
    __syncthreads();
}

struct EpiBranch {
    __device__ __forceinline__ bool idem(const pg8::Unit& u) const { return u.seg != 0; }
    const h16* GA; const h16* GB; h16* MERGED;
    __device__ __forceinline__ bool operator()(pg8::Acc& acc, const pg8::Unit& u, const pg8::Unit& nxt, bool has_next, int ui, int wr, int wc, int fr, int fq, int wid, int lane, LAS unsigned char* scr) const {
        const int row0 = u.pm * 256 + wr * 64 + fr, cb = u.pn * 256 + 32 * wc + 8 * fq;
#pragma unroll
        for (int ai = 0; ai < 2; ++ai) {
            u32x4 gbv[4][2], gav[4][2];
#pragma unroll
            for (int m = 0; m < 4; ++m)
#pragma unroll
                for (int bj = 0; bj < 2; ++bj) { const size_t ro = (size_t)(row0 + ai * 128 + m * 16) * 1024 + cb + 128 * bj; gbv[m][bj] = *(const u32x4*)(GB + ro); if (u.seg == 0) gav[m][bj] = *(const u32x4*)(GA + ro); }
#pragma unroll
            for (int m = 0; m < 4; ++m)
#pragma unroll
                for (int bj = 0; bj < 2; ++bj) { const size_t ro = (size_t)(row0 + ai * 128 + m * 16) * 1024 + cb + 128 * bj;
                    f32x4 b0, b1; unpk8(gbv[m][bj], b0, b1);
                    if (u.seg == 0) { f32x4 a0, a1; unpk8(gav[m][bj], a0, a1);
#pragma unroll
                        for (int j = 0; j < 4; ++j) { acc[ai][bj][m][0][j] *= a0[j] * __builtin_amdgcn_rcpf(b0[j]); acc[ai][bj][m][1][j] *= a1[j] * __builtin_amdgcn_rcpf(b1[j]); } }
                    else *(u32x4*)(MERGED + ro) = pkh8(acc[ai][bj][m][0] * b0, acc[ai][bj][m][1] * b1); }
        }
        return u.seg != 0;
    }
};

__device__ __forceinline__ h16* x1h_base(unsigned char* ws, int pm) { return pm < X1H_SPLIT ? (h16*)(ws + WS_X1HA) : (h16*)(ws + WS_X1HB) - (size_t)X1H_SPLIT * 256 * 1024; }
struct EpiOut {
    __device__ __forceinline__ bool idem(const pg8::Unit&) const { return true; }
    const float* x; const float* g_ffn; const float* MOD; unsigned char* ws; h16* A2; float* SSQ;
    __device__ __forceinline__ bool operator()(pg8::Acc& acc, const pg8::Unit& u, const pg8::Unit& nxt, bool has_next, int ui, int wr, int wc, int fr, int fq, int wid, int lane, LAS unsigned char* scr) const {
        const int row0 = u.pm * 256 + wr * 64 + fr, cb = u.pn * 256 + 32 * wc + 8 * fq, b = u.pm >> 4;
        h16* X1H = x1h_base(ws, u.pm);
        f32x4 gt[2][2], g2[2][2];
#pragma unroll
        for (int bj = 0; bj < 2; ++bj)
#pragma unroll
            for (int n = 0; n < 2; ++n) { const int c = cb + 128 * bj + 4 * n; gt[bj][n] = *(const f32x4*)(MOD + b * 6144 + 2048 + c);
                g2[bj][n] = *(const f32x4*)(g_ffn + c) * (*(const f32x4*)(MOD + b * 6144 + 4096 + c) + 1.f); }
#pragma unroll
        for (int ai = 0; ai < 2; ++ai)
#pragma unroll
          for (int mp = 0; mp < 2; ++mp) {
            f32x4 xv[2][2][2];
#pragma unroll
            for (int mm = 0; mm < 2; ++mm)
#pragma unroll
                for (int bj = 0; bj < 2; ++bj) { const float* xp = x + (size_t)(row0 + ai * 128 + (2 * mp + mm) * 16) * 1024 + cb + 128 * bj; xv[mm][bj][0] = *(const f32x4*)xp; xv[mm][bj][1] = *(const f32x4*)(xp + 4); }
#pragma unroll
            for (int mm = 0; mm < 2; ++mm) { const int m = 2 * mp + mm; const int row = row0 + ai * 128 + m * 16; const size_t ro = (size_t)row * 1024 + cb; float s = 0.f;
#pragma unroll
                for (int bj = 0; bj < 2; ++bj) {
                    const f32x4 y0 = xv[mm][bj][0] + gt[bj][0] * acc[ai][bj][m][0], y1 = xv[mm][bj][1] + gt[bj][1] * acc[ai][bj][m][1];
                    *(u32x4*)(X1H + ro + 128 * bj) = pkh8(y0, y1);
                    *(u32x4*)(A2 + ro + 128 * bj) = pkh8(y0 * g2[bj][0], y1 * g2[bj][1]);
                    s += (y0[0] * y0[0] + y0[1] * y0[1]) + (y0[2] * y0[2] + y0[3] * y0[3]) + (y1[0] * y1[0] + y1[1] * y1[1]) + (y1[2] * y1[2] + y1[3] * y1[3]); }
                s += __shfl_xor(s, 16); s += __shfl_xor(s, 32);
                if (fq == 0) SSQ[(size_t)row * 16 + 4 * u.pn + wc] = s; }
          }
        return true;
    }
};

template <int NAI>
struct EpiGUT {
    int noepi;
    __device__ __forceinline__ bool idem(const pg8::Unit&) const { return true; }
    const float* SSQ; const float* BIAS2; h16* ACT;
    __device__ __forceinline__ bool operator()(pg8::Acc& acc, const pg8::Unit& u, const pg8::Unit& nxt, bool has_next, int ui, int wr, int wc, int fr, int fq, int wid, int lane, LAS unsigned char* scr) const {
        if (noepi) return true;
        const int tid = wid * 64 + lane, b = u.pm >> 4;
        LAS float* R = (LAS float*)(scr + SCR_R) + (ui & 1) * 256; LAS float* Rn = (LAS float*)(scr + SCR_R) + ((ui + 1) & 1) * 256;
        f32x4 bs[2][2];
#pragma unroll
        for (int bj = 0; bj < 2; ++bj)
#pragma unroll
            for (int n = 0; n < 2; ++n) bs[bj][n] = *(const f32x4*)(BIAS2 + b * NGU + u.pn * 256 + 128 * bj + 32 * wc + 16 * n + 4 * fq);
        if (ui == 0) {
            if (tid < 256) { const float* sp = SSQ + (size_t)(u.pm * 256 + tid) * 16; const f32x4 s0 = *(const f32x4*)sp, s1 = *(const f32x4*)(sp + 4), s2 = *(const f32x4*)(sp + 8), s3 = *(const f32x4*)(sp + 12);
                const f32x4 s = (s0 + s1) + (s2 + s3); R[tid] = rsqrtf(((s[0] + s[1]) + (s[2] + s[3])) * (1.f / 1024.f) + EPS); }
            EPI_LWAIT_BAR();
        }
        f32x4 n0, n1, n2, n3; const bool donext = has_next && tid < 256;
        if (donext) { const float* sp = SSQ + (size_t)(nxt.pm * 256 + tid) * 16; n0 = *(const f32x4*)sp; n1 = *(const f32x4*)(sp + 4); n2 = *(const f32x4*)(sp + 8); n3 = *(const f32x4*)(sp + 12); }
#pragma unroll
        for (int ai = 0; ai < NAI; ++ai)
#pragma unroll
            for (int m = 0; m < 4; ++m) { const int rowl = (NAI == 1 ? u.seg : ai) * 128 + wr * 64 + m * 16 + fr; const float r = R[rowl]; h16* rp = ACT + (size_t)(u.pm * 256 + rowl) * DFF + 128 * u.pn + 16 * wc + 4 * fq;
#pragma unroll
                for (int bj = 0; bj < 2; ++bj) { const f32x4 g = acc[ai][bj][m][0] * r + bs[bj][0], uu = acc[ai][bj][m][1] * r + bs[bj][1]; f32x4 o;
#pragma unroll
                    for (int j = 0; j < 4; ++j) o[j] = g[j] * sigmoidf_(g[j]) * uu[j];
                    *(u32x2*)(rp + 64 * bj) = pkh4(o); } }
        if (donext) { const f32x4 s = (n0 + n1) + (n2 + n3); Rn[tid] = rsqrtf(((s[0] + s[1]) + (s[2] + s[3])) * (1.f / 1024.f) + EPS); }
        return true;
    }
};

struct EpiDown {
    __device__ __forceinline__ bool idem(const pg8::Unit&) const { return true; }
    const float* MOD; unsigned char* ws; float* out;
    __device__ __forceinline__ bool operator()(pg8::Acc& acc, const pg8::Unit& u, const pg8::Unit& nxt, bool has_next, int ui, int wr, int wc, int fr, int fq, int wid, int lane, LAS unsigned char* scr) const {
        const int row0 = u.pm * 256 + wr * 64 + fr, cb = u.pn * 256 + 32 * wc + 8 * fq, b = u.pm >> 4;
        const h16* X1H = x1h_base(ws, u.pm);
        f32x4 gt[2][2];
#pragma unroll
        for (int bj = 0; bj < 2; ++bj)
#pragma unroll
            for (int n = 0; n < 2; ++n) gt[bj][n] = *(const f32x4*)(MOD + b * 6144 + 5120 + cb + 128 * bj + 4 * n);
#pragma unroll
        for (int ai = 0; ai < 2; ++ai) {
            u32x4 xh[4][2];
#pragma unroll
            for (int m = 0; m < 4; ++m)
#pragma unroll
                for (int bj = 0; bj < 2; ++bj) xh[m][bj] = *(const u32x4*)(X1H + (size_t)(row0 + ai * 128 + m * 16) * 1024 + cb + 128 * bj);
#pragma unroll
            for (int m = 0; m < 4; ++m) { const size_t ro = (size_t)(row0 + ai * 128 + m * 16) * 1024 + cb;
#pragma unroll
                for (int bj = 0; bj < 2; ++bj) { float* p = out + ro + 128 * bj; f32x4 xa, xb; unpk8(xh[m][bj], xa, xb);
                    *(f32x4*)p = xa + gt[bj][0] * acc[ai][bj][m][0]; *(f32x4*)(p + 4) = xb + gt[bj][1] * acc[ai][bj][m][1]; } }
        }
        return true;
    }
};


#ifndef REP_MM
#define REP_MM 1
#endif
#ifndef REP_SEL
#define REP_SEL 1
#endif
#ifndef REP_MOBA
#define REP_MOBA 1
#endif
namespace idxp {
typedef float f32x16 __attribute__((ext_vector_type(16)));
typedef float f32x2 __attribute__((ext_vector_type(2)));
typedef short s16x2 __attribute__((ext_vector_type(2)));
constexpr int LDS_S = 0, LDS_H = 131072, LDS_WT = LDS_H + 16384, LDS_KM = 0;
static_assert(LDS_WT + 512 <= MISC_OFF, "indexer LDS map");
__device__ __forceinline__ unsigned fkey16(float sc) {
    const short hb = __builtin_bit_cast(short, (h16)sc);
    return (unsigned)(unsigned short)(hb ^ (short)((hb >> 15) | (short)0x8000));
}
__device__ __forceinline__ unsigned suffix_sum(unsigned v, int lane) {
#pragma unroll
    for (int o = 1; o < 64; o <<= 1) { const unsigned u = __shfl_down(v, o); v += (lane + o < 64) ? u : 0u; }
    return v;
}
__device__ __forceinline__ unsigned prefix_sum_incl(unsigned v, int lane) {
#pragma unroll
    for (int o = 1; o < 64; o <<= 1) { const unsigned u = __shfl_up(v, o); v += (lane >= o) ? u : 0u; }
    return v;
}
__device__ __forceinline__ void find_bin(const LAS unsigned* H, unsigned K, int lane, unsigned& bin, unsigned& above, unsigned& inbin) {
    const u32x4 h = *(const LAS u32x4*)(H + 4 * lane);
    const unsigned s = (h[0] + h[1]) + (h[2] + h[3]);
    const unsigned S = suffix_sum(s, lane), ab = S - s;
    const bool mine = ab < K && K <= S;
    unsigned c = ab, bsel = 0, asel = 0, isel = 0; bool done = false;
#pragma unroll
    for (int j = 3; j >= 0; --j) { if (!done && c + h[j] >= K) { bsel = 4 * lane + j; asel = c; isel = h[j]; done = true; } c += h[j]; }
    const unsigned long long bm = __ballot(mine);
    const int ls = __builtin_amdgcn_readfirstlane(bm ? __ffsll((long long)bm) - 1 : 0);
    bin = __builtin_amdgcn_readlane(bsel, ls); above = __builtin_amdgcn_readlane(asel, ls); inbin = __builtin_amdgcn_readlane(isel, ls);
}
__device__ __forceinline__ void find_bin9(const LAS unsigned* H, unsigned K, int lane, unsigned& bin, unsigned& above) {
    const u32x4 h = *(const LAS u32x4*)(H + 4 * lane);
    unsigned cnt[8];
#pragma unroll
    for (int j = 0; j < 8; ++j) cnt[j] = (h[j >> 1] >> (16 * (j & 1))) & 0xffffu;
    const unsigned s = ((cnt[0] + cnt[1]) + (cnt[2] + cnt[3])) + ((cnt[4] + cnt[5]) + (cnt[6] + cnt[7]));
    const unsigned S = suffix_sum(s, lane), ab = S - s;
    const bool mine = ab < K && K <= S;
    unsigned c = ab, bsel = 0, asel = 0; bool done = false;
#pragma unroll
    for (int j = 7; j >= 0; --j) { if (!done && c + cnt[j] >= K) { bsel = 8 * lane + j; asel = c; done = true; } c += cnt[j]; }
    const unsigned long long bm = __ballot(mine);
    const int ls = __builtin_amdgcn_readfirstlane(bm ? __ffsll((long long)bm) - 1 : 0);
    bin = __builtin_amdgcn_readlane(bsel, ls); above = __builtin_amdgcn_readlane(asel, ls);
}
constexpr int CV_A = 8 * 32, CV_OUT = 16 * 32, CV_GU = 16 * (NGU / 32), CV_DN = (DFF / 64) * 32, CV_BLOCKS = 2 * CV_A + CV_OUT + CV_GU + CV_DN, CV_STEPS = CV_BLOCKS / NWAVES;
static_assert(CV_BLOCKS % NWAVES == 0 && CV_STEPS <= 768, "late conversion steps fit the first three indexer items of every workgroup");
struct CvtLate { const float* src; h16* dst; int ldw, K; };
__device__ __forceinline__ CvtLate cvt_late_addr(const Args& a, int blk, int lane) {
    const float* W; h16* WT; int ldw, K, ngrp, r = blk; bool gu = false; unsigned char* ws = a.ws;
    if (r < CV_A) { W = a.w_br_dsa; WT = (h16*)(ws + WS_WA); ldw = 1024; K = 512; ngrp = 32; }
    else if (r < 2 * CV_A) { r -= CV_A; W = a.w_br_moba; WT = (h16*)(ws + WS_WB); ldw = 1024; K = 512; ngrp = 32; }
    else if (r < 2 * CV_A + CV_OUT) { r -= 2 * CV_A; W = a.w_out; WT = (h16*)(ws + WS_WOUT); ldw = 1024; K = 1024; ngrp = 32; }
    else if (r < 2 * CV_A + CV_OUT + CV_GU) { r -= 2 * CV_A + CV_OUT; W = a.w_gate_up; WT = (h16*)(ws + WS_WGU); ldw = NGU; K = 1024; ngrp = NGU / 32; gu = true; }
    else { r -= 2 * CV_A + CV_OUT + CV_GU; W = a.w_down; WT = (h16*)(ws + WS_WDN); ldw = 1024; K = DFF; ngrp = 32; }
    const int kb = r / ngrp, grp = r - kb * ngrp, ko = lane & 7, cp = 32 * grp + 4 * (lane >> 3);
    const int sc = gu ? MapGU{}(cp) : MapPlain{}(cp);
    CvtLate c; c.src = W + (size_t)(64 * kb + 8 * ko) * ldw + sc; c.dst = WT + (size_t)cp * K + 64 * kb + 8 * ko; c.ldw = ldw; c.K = K; return c;
}
__device__ __forceinline__ void idx_item(const Args& a, int cstep, const h16* QI, const h16* KI, const float* WI, u64* MASK, LAS unsigned char* lds, int b, int i, int tid, int lane, int wave) {
    asm volatile("" : "+v"(lane));
    LAS unsigned short* S = (LAS unsigned short*)(lds + LDS_S);
    const int t0 = 16 * i, c = lane & 31, hh = lane >> 5;
    const int n32 = (t0 + 15) / 32 + 1;
    const int nwords = 4 * (t0 >> 8) + 4;
    const int nit = (nwords + 7) / 8;
    const int n32z = nit * 16;
    f16x8 A[4][4]; f32x4 wl[4][4];
    LAS unsigned* HA = (LAS unsigned*)(lds + LDS_H);
    *(LAS u32x4*)(HA + 8 * tid) = (u32x4){0u, 0u, 0u, 0u}; *(LAS u32x4*)(HA + 8 * tid + 4) = (u32x4){0u, 0u, 0u, 0u};
    LAS float* WT = (LAS float*)(lds + LDS_WT);
    if (tid < 128) { const float wv = WI[(size_t)(b * S_ + t0) * 8 + tid]; WT[tid] = wv > 0.f ? __builtin_inff() : -__builtin_inff(); }
    { const int rho = lane & 31, qq = 2 * ((rho >> 2) & 1) + (rho >> 4), head = (rho & 3) + 4 * ((rho >> 3) & 1);
#pragma unroll
      for (int rt = 0; rt < 4; ++rt) { const h16* qp = QI + (size_t)(b * S_ + t0 + 4 * rt + qq) * 512 + head * 64 + 8 * hh;
#pragma unroll
          for (int ks = 0; ks < 4; ++ks) A[rt][ks] = *(const f16x8*)(qp + 16 * ks);
          { const float* wp_ = WI + (size_t)(b * S_ + t0 + 4 * rt + 2 * hh) * 8;
#pragma unroll
            for (int e4 = 0; e4 < 4; ++e4) { const f32x4 wq = *(const f32x4*)(wp_ + 4 * e4);
#pragma unroll
                for (int j = 0; j < 4; ++j) wl[rt][e4][j] = wq[j] > 0.f ? __builtin_inff() : -__builtin_inff(); } }
          const float wv = WI[(size_t)(b * S_ + t0 + 4 * rt + qq) * 8 + head];
#pragma unroll
          for (int ks = 0; ks < 4; ++ks)
#pragma unroll
              for (int e = 0; e < 8; ++e) A[rt][ks][e] = (h16)((float)A[rt][ks][e] * wv); } }
    __syncthreads();
    f16x8 bf[4];
    if (wave < n32) { const h16* kp = KI + (size_t)(b * S_ + 32 * wave + c) * 64 + 8 * hh;
#pragma unroll
        for (int ks = 0; ks < 4; ++ks) bf[ks] = *(const f16x8*)(kp + 16 * ks); }
    for (int kt = wave; kt < n32; kt += NWAVES) {
        f16x8 bn[4];
        { const int ktn = kt + NWAVES < n32 ? kt + NWAVES : kt; const h16* kp = KI + (size_t)(b * S_ + 32 * ktn + c) * 64 + 8 * hh;
#pragma unroll
          for (int ks = 0; ks < 4; ++ks) bn[ks] = *(const f16x8*)(kp + 16 * ks); }
        const int s = 32 * kt + c;
        f32x16 acc[4];
#pragma unroll
        for (int rt = 0; rt < 4; ++rt) acc[rt] = f32x16{};
#pragma unroll
        for (int ks = 0; ks < 4; ++ks)
#pragma unroll
            for (int rt = 0; rt < 4; ++rt) acc[rt] = __builtin_amdgcn_mfma_f32_32x32x16_f16(A[rt][ks], bf[ks], acc[rt], 0, 0, 0);
        const bool diag = 32 * kt + 31 > t0;
#pragma unroll
        for (int rt = 0; rt < 4; ++rt) {
            const int q0 = 4 * rt + 2 * hh;
            const f32x4 w0 = wl[rt][0], w1 = wl[rt][1], w2 = wl[rt][2], w3 = wl[rt][3];
            float s0, s1;
#define MD(r_, w_) __builtin_amdgcn_fmed3f(acc[rt][r_], 0.f, w_)
            { const f32x2 u0 = {MD(0, w0[0]), MD(1, w0[1])}, u1 = {MD(2, w0[2]), MD(3, w0[3])}, u2 = {MD(4, w1[0]), MD(5, w1[1])}, u3 = {MD(6, w1[2]), MD(7, w1[3])};
              const f32x2 t = (u0 + u1) + (u2 + u3); s0 = t[0] + t[1]; }
            { const f32x2 u0 = {MD(8, w2[0]), MD(9, w2[1])}, u1 = {MD(10, w2[2]), MD(11, w2[3])}, u2 = {MD(12, w3[0]), MD(13, w3[1])}, u3 = {MD(14, w3[2]), MD(15, w3[3])};
              const f32x2 t = (u0 + u1) + (u2 + u3); s1 = t[0] + t[1]; }
#undef MD
            unsigned keys = pkh(s0, s1);
            { const s16x2 sg = __builtin_bit_cast(s16x2, keys) >> (s16x2){15, 15}; keys ^= __builtin_bit_cast(unsigned, sg) | 0x80008000u; }
            LAS unsigned* h0 = HA + q0 * 256;
            if (diag) { if (!(s <= t0 + q0)) keys &= 0xffff0000u; if (!(s <= t0 + q0 + 1)) keys &= 0x0000ffffu;
                if (keys & 0xffffu) (void)__hip_atomic_fetch_add(h0 + ((keys >> 8) & 0xffu), ((keys >> 7) & 1u) * 0xffffu + 1u, __ATOMIC_RELAXED, __HIP_MEMORY_SCOPE_WORKGROUP);
                if (keys >> 16) (void)__hip_atomic_fetch_add(h0 + 256 + (keys >> 24), ((keys >> 23) & 1u) * 0xffffu + 1u, __ATOMIC_RELAXED, __HIP_MEMORY_SCOPE_WORKGROUP); }
            else { (void)__hip_atomic_fetch_add(h0 + ((keys >> 8) & 0xffu), ((keys >> 7) & 1u) * 0xffffu + 1u, __ATOMIC_RELAXED, __HIP_MEMORY_SCOPE_WORKGROUP);
                   (void)__hip_atomic_fetch_add(h0 + 256 + (keys >> 24), ((keys >> 23) & 1u) * 0xffffu + 1u, __ATOMIC_RELAXED, __HIP_MEMORY_SCOPE_WORKGROUP); }
            const unsigned k0 = keys & 0xffffu, k1 = keys >> 16;
            S[q0 * 4096 + s] = (unsigned short)k0; S[(q0 + 1) * 4096 + s] = (unsigned short)k1;
        }
#pragma unroll
        for (int ks = 0; ks < 4; ++ks) bf[ks] = bn[ks];
    }
    for (int kt = n32 + wave; kt < n32z; kt += NWAVES) {
#pragma unroll
        for (int q = 0; q < 16; q += 2) S[(q + hh) * 4096 + 32 * kt + c] = (unsigned short)0;
    }
    __syncthreads();
    f32x4 wv[8]; CvtLate cv;
    if (cstep >= 0) { cv = cvt_late_addr(a, __builtin_amdgcn_readfirstlane(cstep * NWAVES + wave), lane);
#pragma unroll
        for (int k = 0; k < 8; ++k) wv[k] = *(const f32x4*)(cv.src + (size_t)k * cv.ldw); }
    u64* Mb = MASK + (size_t)b * 64 * S_;
    for (int rr = 0; rr < 2; ++rr) {
        const int q = 2 * wave + rr, t = t0 + q, N = t + 1;
        const LAS unsigned short* Srow = S + q * 4096; LAS unsigned* H = HA + q * 256;
        if (N <= TOPK) {
            if (lane < nwords) { const int n = t - 64 * lane + 1; const u64 m = n >= 64 ? ~0ull : n <= 0 ? 0ull : ((1ull << n) - 1ull); Mb[(size_t)lane * S_ + t] = m; }
            continue;
        }
        u32x4 kv[8];
#pragma unroll
        for (int it = 0; it < 8; ++it) kv[it] = it < nit ? *(const LAS u32x4*)(Srow + (it * 64 + lane) * 8) : (u32x4){0u, 0u, 0u, 0u};
        unsigned binA, cntA; find_bin9(H, (unsigned)TOPK, lane, binA, cntA);
        LDS_WAIT(); *(LAS u32x4*)(H + 4 * lane) = (u32x4){0u, 0u, 0u, 0u}; LDS_WAIT();
#pragma unroll
        for (int it = 0; it < 8; ++it) if (it < nit) {
#pragma unroll
            for (int e = 0; e < 8; ++e) { const unsigned k = (kv[it][e >> 1] >> (16 * (e & 1))) & 0xffffu; if ((k >> 7) == binA) (void)__hip_atomic_fetch_add(H + (k & 127u), 1u, __ATOMIC_RELAXED, __HIP_MEMORY_SCOPE_WORKGROUP); } }
        LDS_WAIT();
        unsigned binB, cntB, ties; find_bin(H, (unsigned)TOPK - cntA, lane, binB, cntB, ties);
        const unsigned Tk = (binA << 7) | binB, need = (unsigned)TOPK - (cntA + cntB);
        LDS_WAIT();
        unsigned taken = 0;
#pragma unroll
        for (int it = 0; it < 8; ++it) if (it < nit) {
            unsigned selb = 0;
            if (ties == need) {
#pragma unroll
                for (int e = 0; e < 8; ++e) { const unsigned k = (kv[it][e >> 1] >> (16 * (e & 1))) & 0xffffu; selb |= (k >= Tk ? 1u : 0u) << e; }
            } else {
                unsigned eq = 0;
#pragma unroll
                for (int e = 0; e < 8; ++e) { const unsigned k = (kv[it][e >> 1] >> (16 * (e & 1))) & 0xffffu; selb |= (k > Tk ? 1u : 0u) << e; eq |= (k == Tk ? 1u : 0u) << e; }
                if (__any(eq != 0u)) {
                    const unsigned cl = __popc(eq), incl = prefix_sum_incl(cl, lane); unsigned rank = taken + incl - cl;
#pragma unroll
                    for (int e = 0; e < 8; ++e) if ((eq >> e) & 1u) { if (rank < need) selb |= 1u << e; ++rank; }
                    taken += __builtin_amdgcn_readlane(incl, 63);
                }
            }
            u64 v = (u64)selb << (8 * (lane & 7));
            v |= __shfl_xor(v, 1); v |= __shfl_xor(v, 2); v |= __shfl_xor(v, 4);
            const int word = it * 8 + (lane >> 3);
            if ((lane & 7) == 0 && word < nwords) Mb[(size_t)word * S_ + t] = v;
        }
    }
    if (cstep >= 0) {
#pragma unroll
        for (int j = 0; j < 4; ++j) { u32x4 o; o.x = pkh(wv[0][j], wv[1][j]); o.y = pkh(wv[2][j], wv[3][j]); o.z = pkh(wv[4][j], wv[5][j]); o.w = pkh(wv[6][j], wv[7][j]);
            *(u32x4*)(cv.dst + (size_t)j * cv.K) = o; } }
    __syncthreads();
}
__device__ __forceinline__ void moba_select(const h16* QB, const h16* QBL, const float* KMEAN, unsigned* M16, u64* MKB, LAS unsigned char* lds, int bh, int blk, int tid) {
    LAS h16* KMh = (LAS h16*)(lds + LDS_KM); LAS h16* KMl = KMh + NBLK * HD; LAS float* Gt = (LAS float*)(lds + LDS_KM + 8192);
    for (int e = tid; e < NBLK * HD; e += NWAVES * 64) { const float km = KMEAN[(size_t)bh * NBLK * HD + e]; const h16 hv = (h16)km; KMh[e] = hv; KMl[e] = (h16)(km - (float)hv); }
    __syncthreads();
    const int b = bh >> 2, h = bh & 3, lane = tid & 63, wave = tid >> 6, c = lane & 31, hh = lane >> 5;
    if (blk > 0) {
        const size_t qo = (size_t)(b * S_ + 256 * blk + 32 * wave + c) * HW + h * HD + 8 * hh;
        f32x16 acc = {};
#pragma unroll
        for (int ks = 0; ks < 8; ++ks) { const f16x8 qh = *(const f16x8*)(QB + qo + 16 * ks), ql = *(const f16x8*)(QBL + qo + 16 * ks);
            const f16x8 kh = *(const LAS f16x8*)(KMh + (c & 15) * HD + 16 * ks + 8 * hh), kl = *(const LAS f16x8*)(KMl + (c & 15) * HD + 16 * ks + 8 * hh);
            acc = __builtin_amdgcn_mfma_f32_32x32x16_f16(ql, kh, acc, 0, 0, 0); acc = __builtin_amdgcn_mfma_f32_32x32x16_f16(qh, kl, acc, 0, 0, 0); acc = __builtin_amdgcn_mfma_f32_32x32x16_f16(qh, kh, acc, 0, 0, 0); }
        if (c < 16) {
#pragma unroll
            for (int r = 0; r < 16; ++r) Gt[(32 * wave + (r & 3) + 8 * (r >> 2) + 4 * hh) * 16 + c] = acc[r]; }
    }
    __syncthreads();
    if (tid < 256) {
        const int t = 256 * blk + tid;
        float g[NBLK];
#pragma unroll
        for (int j4 = 0; j4 < 4; ++j4) { const f32x4 gv = *(const LAS f32x4*)(Gt + tid * 16 + 4 * j4); g[4 * j4] = gv[0]; g[4 * j4 + 1] = gv[1]; g[4 * j4 + 2] = gv[2]; g[4 * j4 + 3] = gv[3]; }
        float v1 = -3e38f, v2 = -3e38f, v3 = -3e38f; int i1 = -1, i2 = -1, i3 = -1;
#pragma unroll
        for (int j = 0; j < NBLK - 1; ++j) if (j < blk) { const float gg = g[j];
            if (gg > v1) { v3 = v2; i3 = i2; v2 = v1; i2 = i1; v1 = gg; i1 = j; } else if (gg > v2) { v3 = v2; i3 = i2; v2 = gg; i2 = j; } else if (gg > v3) { v3 = gg; i3 = j; } }
        unsigned m = 1u << blk; if (i1 >= 0) m |= 1u << i1; if (i2 >= 0) m |= 1u << i2; if (i3 >= 0) m |= 1u << i3;
        M16[(size_t)bh * S_ + t] = m;
        for (int kt = 0; kt < 4 * blk + 4; ++kt) { const int n = t - 64 * kt + 1; const u64 cm = n >= 64 ? ~0ull : (n <= 0 ? 0ull : ((1ull << n) - 1ull));
            MKB[((size_t)bh * 64 + kt) * S_ + t] = ((m >> (kt >> 2)) & 1u) ? cm : 0ull; }
    }
    __syncthreads();
}
__device__ __forceinline__ void p3_index(const Args& a, LAS unsigned char* lds, int vcu, int G, int tid, int lane, int wave) {
    unsigned char* ws = a.ws;
    const h16* QI = (const h16*)(ws + WS_QI); const h16* KI = (const h16*)(ws + WS_KI); const float* WI = (const float*)(ws + WS_WI); u64* MASK = (u64*)(ws + WS_MASK);
    for (int v = vcu; v < 256; v += G) moba_select((const h16*)(ws + WS_QB), (const h16*)(ws + WS_QBL), (const float*)(ws + WS_KMEAN), (unsigned*)(ws + WS_M16), (u64*)(ws + WS_MASKB), lds, v >> 4, v & 15, tid);
    for (int v = vcu; v < 256; v += G) { const int p = v & 127, bp = v >> 7;
#pragma unroll 1
        for (int k = 0; k < 4; ++k) { const int bb = 2 * bp + ((k == 1 || k == 2) ? 1 : 0), ii = (k & 1) ? p : 255 - p; const int cs = k * 256 + v; idx_item(a, (k < 3 && cs < CV_STEPS) ? cs : -1, QI, KI, WI, MASK, lds, bb, ii, tid, lane, wave); } }
}
}


namespace attp {
typedef float f32x16 __attribute__((ext_vector_type(16)));
typedef short s16x4 __attribute__((ext_vector_type(4)));
constexpr int NW = 8, QBLK = 32, KVBLK = 64, QB = NW * QBLK, D = 128, PITCH = 512;
constexpr int SHM_V = KVBLK * D * 2, SHM_K = KVBLK * D * 2;
constexpr int LDS_M = 2 * SHM_V + 2 * SHM_K + NW * 64 * 4;
constexpr int LDS_ATT = LDS_M + 4096;
constexpr int V_SLOT2 = LDS_ATT, LDS_ATT_END = LDS_ATT + SHM_V;
constexpr float SCALE = 0.08838834764831845f, THR = 8.f;
#define KSWZ(row, colB) ((row) * 256 + ((colB) ^ (((row) & 7) << 4)))
#define SBAR() __builtin_amdgcn_sched_barrier(0)
__device__ __forceinline__ int v_st(int k, int c) { const int kk = (k & ~0xC) | ((k & 4) << 1) | ((k & 8) >> 1); return ((kk >> 3) * 4 + (c >> 5)) * 512 + ((kk & 7) * 32 + (c & 31)) * 2; }
__device__ __forceinline__ int v_rd_base(int lane) { return ((lane & 3) << 3) | (((lane >> 2) & 3) << 6) | (((lane >> 4) & 1) << 5) | (((lane >> 5) & 1) << 8); }
constexpr int v_rd_off(int d0, int ks, int half) { return d0 * 512 + ks * 4096 + half * 2048; }
__device__ __forceinline__ int crow(int r, int hi) { return (r & 3) + 8 * (r >> 2) + 4 * hi; }
__device__ __forceinline__ void mask_apply(f32x16& p0, f32x16& p1, u64 mk, int hi) {
    const unsigned lo = (unsigned)mk >> (4 * hi), hw = (unsigned)(mk >> 32) >> (4 * hi);
    const unsigned NEGI = 0xff800000u;
#pragma unroll
    for (int r = 0; r < 16; ++r) { const int c = (r & 3) + 8 * (r >> 2);
        const unsigned t0 = (unsigned)(((int)(lo << (31 - c))) >> 31), t1 = (unsigned)(((int)(hw << (31 - c))) >> 31);
        p0[r] = __uint_as_float((__float_as_uint(p0[r]) & t0) | (NEGI & ~t0));
        p1[r] = __uint_as_float((__float_as_uint(p1[r]) & t1) | (NEGI & ~t1)); }
}
__device__ __forceinline__ void partialSM(f32x16& p0, f32x16& p1, float& m_reg, float& mn, float& alpha) {
    float pmax = p0[0];
#pragma unroll
    for (int r = 1; r < 16; ++r) pmax = fmaxf(pmax, p0[r]);
#pragma unroll
    for (int r = 0; r < 16; ++r) pmax = fmaxf(pmax, p1[r]);
    { auto rr = __builtin_amdgcn_permlane32_swap(__float_as_uint(pmax), __float_as_uint(pmax), false, false);
      pmax = fmaxf(__uint_as_float(rr[0]), __uint_as_float(rr[1])); }
    constexpr float C2 = 1.4426950408889634f * SCALE;
    if (__builtin_expect(__all((pmax - m_reg) * SCALE <= THR), 1)) { mn = m_reg; alpha = 1.f; }
    else { mn = fmaxf(m_reg, pmax); alpha = __builtin_amdgcn_exp2f((m_reg - mn) * C2); m_reg = mn; }
    const float mnL = -mn * C2;
#pragma unroll
    for (int r = 0; r < 16; ++r) p0[r] = fmaf(p0[r], C2, mnL);
#pragma unroll
    for (int r = 0; r < 16; ++r) p1[r] = fmaf(p1[r], C2, mnL);
#pragma unroll
    for (int r = 0; r < 16; ++r) p0[r] = __builtin_amdgcn_exp2f(p0[r]);
}
__device__ __forceinline__ void finishSM(f32x16& p0, f32x16& p1, float alpha, float& l_reg, f16x8& pa0, f16x8& pa1, f16x8& pa2, f16x8& pa3) {
#pragma unroll
    for (int r = 0; r < 16; ++r) p1[r] = __builtin_amdgcn_exp2f(p1[r]);
    float ps = 0;
#pragma unroll
    for (int r = 0; r < 16; ++r) ps += p0[r];
#pragma unroll
    for (int r = 0; r < 16; ++r) ps += p1[r];
    { auto rr = __builtin_amdgcn_permlane32_swap(__float_as_uint(ps), __float_as_uint(ps), false, false);
      ps = __uint_as_float(rr[0]) + __uint_as_float(rr[1]); }
    l_reg = l_reg * alpha + ps;
#define PK4(P, B_, OUT) do { unsigned a0 = pkh(P[B_+0], P[B_+1]), a1 = pkh(P[B_+2], P[B_+3]);                          \
        unsigned b0 = pkh(P[B_+4], P[B_+5]), b1 = pkh(P[B_+6], P[B_+7]);                                             \
        auto r0 = __builtin_amdgcn_permlane32_swap(a0, b0, false, false); auto r1 = __builtin_amdgcn_permlane32_swap(a1, b1, false, false); \
        u32x4 w = {r0[0], r1[0], r0[1], r1[1]}; OUT = __builtin_bit_cast(f16x8, w); } while (0)
    PK4(p0, 0, pa0); PK4(p0, 8, pa1); PK4(p1, 0, pa2); PK4(p1, 8, pa3);
#undef PK4
}
template <int KB>
__device__ __forceinline__ void qkt(f32x16& p0, f32x16& p1, LAS const char* K_lds, int r32, int hi, const f16x8* qr) {
    p0 = f32x16{}; p1 = f32x16{};
    LAS const char* kb[4];
#pragma unroll
    for (int dd = 0; dd < 4; ++dd) kb[dd] = K_lds + KB * SHM_K + KSWZ(r32, (dd * 16 + hi * 8) * 2);
#pragma unroll
    for (int d0 = 0; d0 < 8; ++d0) { LAS const char* a = kb[d0 & 3] + (d0 >> 2) * 128;
        const f16x8 b0 = *(LAS const f16x8*)a;
        const f16x8 b1 = *(LAS const f16x8*)(a + 32 * 256);
        p0 = __builtin_amdgcn_mfma_f32_32x32x16_f16(b0, qr[d0], p0, 0, 0, 0);
        p1 = __builtin_amdgcn_mfma_f32_32x32x16_f16(b1, qr[d0], p1, 0, 0, 0); }
}
template <int VB>
__device__ __forceinline__ void pv_tile(f32x16* o, int vb0, f16x8 pa0, f16x8 pa1, f16x8 pa2, f16x8 pa3) {
#define TRRD(dst, off) asm volatile("ds_read_b64_tr_b16 %0, %1 offset:%2" : "=&v"(dst) : "v"(vb0), "i"(off) : "memory")
#define PV_D0(d0) do { s16x4 l0, l1, l2, l3, h0, h1, h2, h3; constexpr int b_ = VB * SHM_V + v_rd_off(d0, 0, 0); \
        TRRD(l0, b_); TRRD(h0, b_ + 2048); TRRD(l1, b_ + 4096); TRRD(h1, b_ + 6144); TRRD(l2, b_ + 8192); TRRD(h2, b_ + 10240); TRRD(l3, b_ + 12288); TRRD(h3, b_ + 14336); \
        asm volatile("s_waitcnt lgkmcnt(0)" ::: "memory"); SBAR(); \
        o[d0] = __builtin_amdgcn_mfma_f32_32x32x16_f16(pa0, __builtin_bit_cast(f16x8, (short __attribute__((ext_vector_type(8)))){l0[0], l0[1], l0[2], l0[3], h0[0], h0[1], h0[2], h0[3]}), o[d0], 0, 0, 0);   \
        o[d0] = __builtin_amdgcn_mfma_f32_32x32x16_f16(pa1, __builtin_bit_cast(f16x8, (short __attribute__((ext_vector_type(8)))){l1[0], l1[1], l1[2], l1[3], h1[0], h1[1], h1[2], h1[3]}), o[d0], 0, 0, 0);   \
        o[d0] = __builtin_amdgcn_mfma_f32_32x32x16_f16(pa2, __builtin_bit_cast(f16x8, (short __attribute__((ext_vector_type(8)))){l2[0], l2[1], l2[2], l2[3], h2[0], h2[1], h2[2], h2[3]}), o[d0], 0, 0, 0);   \
        o[d0] = __builtin_amdgcn_mfma_f32_32x32x16_f16(pa3, __builtin_bit_cast(f16x8, (short __attribute__((ext_vector_type(8)))){l3[0], l3[1], l3[2], l3[3], h3[0], h3[1], h3[2], h3[3]}), o[d0], 0, 0, 0); } while (0)
    PV_D0(0); PV_D0(1); PV_D0(2); PV_D0(3);
#undef PV_D0
#undef TRRD
}
template <int VB>
__device__ __forceinline__ void pv_sm(f32x16* o, int vb0, f16x8 pa0, f16x8 pa1, f16x8 pa2, f16x8 pa3, f32x16& p0, f32x16& p1, unsigned lo, unsigned hw, float& m_reg, float& mn, float& alpha) {
    const unsigned NEGI = 0xff800000u;
    constexpr float C2 = 1.4426950408889634f * SCALE;
    float pmax, mnL;
#define PIN2(a, b) asm volatile("" : "+v"(a), "+v"(b))
#define TRRD(dst, off) asm volatile("ds_read_b64_tr_b16 %0, %1 offset:%2" : "=&v"(dst) : "v"(vb0), "i"(off) : "memory")
#define PV_RD(d0) s16x4 l0, l1, l2, l3, h0, h1, h2, h3; { constexpr int b_ = VB * SHM_V + v_rd_off(d0, 0, 0); \
        TRRD(l0, b_); TRRD(h0, b_ + 2048); TRRD(l1, b_ + 4096); TRRD(h1, b_ + 6144); TRRD(l2, b_ + 8192); TRRD(h2, b_ + 10240); TRRD(l3, b_ + 12288); TRRD(h3, b_ + 14336); } SBAR()
#define PV_MM(d0) SBAR(); asm volatile("s_waitcnt lgkmcnt(0)" ::: "memory"); SBAR(); \
        o[d0] = __builtin_amdgcn_mfma_f32_32x32x16_f16(pa0, __builtin_bit_cast(f16x8, (short __attribute__((ext_vector_type(8)))){l0[0], l0[1], l0[2], l0[3], h0[0], h0[1], h0[2], h0[3]}), o[d0], 0, 0, 0);   \
        o[d0] = __builtin_amdgcn_mfma_f32_32x32x16_f16(pa1, __builtin_bit_cast(f16x8, (short __attribute__((ext_vector_type(8)))){l1[0], l1[1], l1[2], l1[3], h1[0], h1[1], h1[2], h1[3]}), o[d0], 0, 0, 0);   \
        o[d0] = __builtin_amdgcn_mfma_f32_32x32x16_f16(pa2, __builtin_bit_cast(f16x8, (short __attribute__((ext_vector_type(8)))){l2[0], l2[1], l2[2], l2[3], h2[0], h2[1], h2[2], h2[3]}), o[d0], 0, 0, 0);   \
        o[d0] = __builtin_amdgcn_mfma_f32_32x32x16_f16(pa3, __builtin_bit_cast(f16x8, (short __attribute__((ext_vector_type(8)))){l3[0], l3[1], l3[2], l3[3], h3[0], h3[1], h3[2], h3[3]}), o[d0], 0, 0, 0)
    { PV_RD(0);
#pragma unroll
      for (int r = 0; r < 16; ++r) { const int c = (r & 3) + 8 * (r >> 2); const unsigned t0 = (unsigned)(((int)(lo << (31 - c))) >> 31);
          p0[r] = __uint_as_float((__float_as_uint(p0[r]) & t0) | (NEGI & ~t0)); }
      pmax = p0[0];
#pragma unroll
      for (int r = 1; r < 16; ++r) pmax = fmaxf(pmax, p0[r]);
      PIN2(p0, pmax); PV_MM(0); }
    { PV_RD(1);
#pragma unroll
      for (int r = 0; r < 16; ++r) { const int c = (r & 3) + 8 * (r >> 2); const unsigned t1 = (unsigned)(((int)(hw << (31 - c))) >> 31);
          p1[r] = __uint_as_float((__float_as_uint(p1[r]) & t1) | (NEGI & ~t1)); }
#pragma unroll
      for (int r = 0; r < 16; ++r) pmax = fmaxf(pmax, p1[r]);
      PIN2(p1, pmax); PV_MM(1); }
    { PV_RD(2);
      { auto rr = __builtin_amdgcn_permlane32_swap(__float_as_uint(pmax), __float_as_uint(pmax), false, false);
        pmax = fmaxf(__uint_as_float(rr[0]), __uint_as_float(rr[1])); }
      if (__builtin_expect(__all((pmax - m_reg) * SCALE <= THR), 1)) { mn = m_reg; alpha = 1.f; }
      else { mn = fmaxf(m_reg, pmax); alpha = __builtin_amdgcn_exp2f((m_reg - mn) * C2); m_reg = mn; }
      mnL = -mn * C2;
#pragma unroll
      for (int r = 0; r < 16; ++r) p0[r] = fmaf(p0[r], C2, mnL);
#pragma unroll
      for (int r = 0; r < 16; ++r) p1[r] = fmaf(p1[r], C2, mnL);
      PIN2(p0, p1); PV_MM(2); }
    { PV_RD(3);
#pragma unroll
      for (int r = 0; r < 16; ++r) p0[r] = __builtin_amdgcn_exp2f(p0[r]);
      PIN2(p0, alpha); PV_MM(3); }
#undef PIN2
#undef PV_RD
#undef PV_MM
#undef TRRD
}
struct BlockRef { const h16* Q; const h16* K; const h16* V; h16* O; const u64* MK; int P0; int pad; };
struct Seam { f16x8 qr[8]; f16x8 st_v0, st_v1, st_k0, st_k1; unsigned st_m; };
#define VMW() asm volatile("s_waitcnt vmcnt(0)" ::: "memory")
#define VMWN(n) asm volatile("s_waitcnt vmcnt(%0)" :: "i"(n) : "memory")
#define SLOAD_H(B_, k0) do { const char* kb_ = (const char*)(B_).K + (size_t)(k0) * (PITCH * 2); const char* vb_ = (const char*)(B_).V + (size_t)(k0) * (PITCH * 2);           \
                         S.st_v0 = *(const f16x8*)(vb_ + kvoff); S.st_v1 = *(const f16x8*)(vb_ + 32 * PITCH * 2 + kvoff);                                   \
                         S.st_k0 = *(const f16x8*)(kb_ + kvoff); S.st_k1 = *(const f16x8*)(kb_ + 32 * PITCH * 2 + kvoff);                                   \
                         S.st_m = *(const unsigned*)((const char*)((B_).MK + (size_t)((k0) / KVBLK) * S_ + (B_).P0 + wid * QBLK) + moff); } while (0)
#define SWRITE_HK(bf) do { *(LAS f16x8*)(K_lds + (bf) * SHM_K + kws) = S.st_k0; *(LAS f16x8*)(K_lds + (bf) * SHM_K + kws + 32 * 256) = S.st_k1; } while (0)
#define SWRITE_HV(voff, bf) do { *(LAS f16x8*)(V_lds + (voff) + vst0) = S.st_v0; *(LAS f16x8*)(V_lds + (voff) + vst1) = S.st_v1; \
                           *(LAS unsigned*)(lds + LDS_M + (bf) * 2048 + wid * 256 + lane * 4) = S.st_m; } while (0)
#define SWRITE_H(voff, bf) do { SWRITE_HV(voff, bf); SWRITE_HK(bf); } while (0)
__device__ __forceinline__ void attn_prime(const BlockRef& cur, LAS char* lds, Seam& S) {
    int tid = threadIdx.x; asm volatile("" : "+v"(tid));
    const int wid = __builtin_amdgcn_readfirstlane(tid >> 6), lane = tid & 63, r32 = lane & 31, hi = lane >> 5;
    const int sr = tid >> 4, sc = (tid & 15) * 8, kws = KSWZ(sr, sc * 2); LAS char* K_lds = lds + 2 * SHM_V;
    const unsigned kvoff = (unsigned)(sr * PITCH + sc) * 2u, moff = (unsigned)lane * 4u, qoff = (unsigned)((wid * QBLK + r32) * PITCH + hi * 8) * 2u;
#pragma unroll
    for (int d0 = 0; d0 < 8; ++d0) S.qr[d0] = *(const f16x8*)((const char*)cur.Q + qoff + d0 * 32);
    SLOAD_H(cur, 0); VMW(); SWRITE_HK(0);
    __syncthreads();
}
__device__ __forceinline__ void attn_block(const BlockRef& cur, const BlockRef& nxt, LAS char* lds, Seam& S) {
    int tid = threadIdx.x; asm volatile("" : "+v"(tid));
    const int wid = __builtin_amdgcn_readfirstlane(tid >> 6), lane = tid & 63, r32 = lane & 31, hi = lane >> 5;
    const unsigned kvoff = (unsigned)((tid >> 4) * PITCH + (tid & 15) * 8) * 2u, moff = (unsigned)lane * 4u, qoff = (unsigned)((wid * QBLK + r32) * PITCH + hi * 8) * 2u;
    const int NT = cur.P0 / KVBLK + 4;
    LAS char* V_lds = lds; LAS char* K_lds = lds + 2 * SHM_V;
    LAS float* wsf = (LAS float*)(lds + 2 * SHM_V + 2 * SHM_K) + wid * 64; LAS float* li_l = wsf; LAS float* al_l = wsf + 32;
    float m_reg = -1e30f, l_reg = 0; f32x16 o[4] = {};
    const int sr = tid >> 4, sc = (tid & 15) * 8, vst0 = v_st(sr, sc), vst1 = v_st(32 + sr, sc), kws = KSWZ(sr, sc * 2);
    const int vb0 = (int)(unsigned)(uintptr_t)V_lds + v_rd_base(lane);
#define RESC(a) do { if (__any((a) < 1.f)) { if (hi == 0) al_l[r32] = (a); asm volatile("s_waitcnt lgkmcnt(0)" ::: "memory");              \
                     _Pragma("unroll") for (int d_ = 0; d_ < 4; ++d_) _Pragma("unroll") for (int r = 0; r < 16; ++r) o[d_][r] *= al_l[crow(r, hi)]; } } while (0)
#define KBASE(t) ((t) * KVBLK)
#define MKGET(bf) (*(const LAS u64*)(lds + LDS_M + (bf) * 2048 + wid * 256 + r32 * 8))
#define SEAM_K0() do { VMWN(8); SWRITE_HK(0); SBAR(); } while (0)
    f32x16 pA0, pA1, pB0, pB1; float mnA, mnB, alA, alB; f16x8 pa0, pa1, pa2, pa3;
    SWRITE_HV(0, 0); SBAR();
    if (NT > 1) SLOAD_H(cur, KBASE(1));
    SBAR(); qkt<0>(pA0, pA1, K_lds, r32, hi, S.qr);
    mask_apply(pA0, pA1, MKGET(0), hi); partialSM(pA0, pA1, m_reg, mnA, alA);
    if (NT > 1) { VMW(); SWRITE_H(SHM_V, 1); }
    __syncthreads();
    int va = 0, vn = SHM_V, vc = V_SLOT2;
#define HALF_STEP(PX0, PX1, mnX, alX, PY0, PY1, alY, t, KB, VB, SB) do {                                                      \
        SBAR(); unsigned mlo_, mhw_; { const u64 mk_ = MKGET(KB); mlo_ = (unsigned)mk_ >> (4 * hi); mhw_ = (unsigned)(mk_ >> 32) >> (4 * hi); } \
        qkt<KB>(PX0, PX1, K_lds, r32, hi, S.qr);                                                                               \
        finishSM(PY0, PY1, alY, l_reg, pa0, pa1, pa2, pa3); asm volatile("" : "+v"(mlo_), "+v"(mhw_)); SBAR();               \
        if ((t) + 1 < NT) { SLOAD_H(cur, KBASE((t) + 1)); SBAR(); }                                                        \
        pv_sm<0>(o, vb0 + va, pa0, pa1, pa2, pa3, PX0, PX1, mlo_, mhw_, m_reg, mnX, alX);                                          \
        if ((t) + 1 < NT) { VMW(); SWRITE_H(vc, SB); }                                                                        \
        RESC(alX); __syncthreads(); { const int t_ = va; va = vn; vn = vc; vc = t_; } } while (0)
    for (int t = 1; t + 1 < NT; t += 2) {
        HALF_STEP(pB0, pB1, mnB, alB, pA0, pA1, alA, t, 1, 0, 0);
        HALF_STEP(pA0, pA1, mnA, alA, pB0, pB1, alB, t + 1, 0, 1, 1);
    }
    const bool even = (NT & 1) == 0;
    if (even) { SBAR(); qkt<1>(pB0, pB1, K_lds, r32, hi, S.qr); SBAR(); }
    SLOAD_H(nxt, 0); SBAR();
#pragma unroll
    for (int d0 = 0; d0 < 8; ++d0) S.qr[d0] = *(const f16x8*)((const char*)nxt.Q + qoff + d0 * 32);
    SBAR();
    finishSM(pA0, pA1, alA, l_reg, pa0, pa1, pa2, pa3); SBAR();
    pv_tile<0>(o, vb0 + va, pa0, pa1, pa2, pa3);
    if (even) { mask_apply(pB0, pB1, MKGET(1), hi); partialSM(pB0, pB1, m_reg, mnB, alB); __syncthreads(); RESC(alB);
        finishSM(pB0, pB1, alB, l_reg, pa0, pa1, pa2, pa3); SBAR(); pv_tile<0>(o, vb0 + vn, pa0, pa1, pa2, pa3); }
    SBAR(); SEAM_K0();
    if (hi == 0) li_l[r32] = l_reg; asm volatile("s_waitcnt lgkmcnt(0)" ::: "memory");
    float rli[16];
#pragma unroll
    for (int r = 0; r < 16; ++r) rli[r] = __builtin_amdgcn_rcpf(li_l[crow(r, hi)]);
    char* Ow = (char*)cur.O + (size_t)(wid * QBLK) * (PITCH * 2); const unsigned ooff = (unsigned)(4 * hi * PITCH + r32) * 2u;
#pragma unroll
    for (int r = 0; r < 16; ++r) { const int orow = (r & 3) + 8 * (r >> 2);
#pragma unroll
        for (int d0 = 0; d0 < 4; ++d0) { const float v = o[d0][r] * rli[r];
            const float vn = __shfl_xor(v, 1);
            if ((r32 & 1) == 0) *(unsigned*)(Ow + (size_t)(orow * PITCH + d0 * 32) * 2 + ooff) = pkh(v, vn); } }
    __syncthreads();
#undef RESC
#undef KBASE
#undef MKGET
#undef SEAM_K0
#undef HALF_STEP
}
#undef VMW
#undef VMWN
#undef SLOAD_H
#undef SWRITE_HK
#undef SWRITE_HV
#undef SWRITE_H
__device__ __forceinline__ BlockRef make_ref(unsigned char* ws, int kind, int b, int h, int qb) {
    BlockRef r; const size_t ro = (size_t)(b * S_) * PITCH + h * D;
    const h16* Q = (const h16*)(ws + (kind ? WS_QB : WS_QA)); const h16* K = (const h16*)(ws + (kind ? WS_KB : WS_KA)); const h16* V = (const h16*)(ws + (kind ? WS_VB : WS_VA));
    h16* O = (h16*)(ws + (kind ? WS_QBL : WS_QI));
    r.Q = Q + ro + (size_t)(qb * QB) * PITCH; r.K = K + ro; r.V = V + ro; r.O = O + ro + (size_t)(qb * QB) * PITCH;
    r.MK = kind ? (const u64*)(ws + WS_MASKB) + (size_t)(b * NH + h) * 64 * S_ : (const u64*)(ws + WS_MASK) + (size_t)b * 64 * S_; r.P0 = qb * QB; r.pad = 0;
    return r;
}
__device__ __forceinline__ void p4_attention(const Args& a, LAS unsigned char* lds, int vcu, int G) {
    for (int v = vcu; v < 256; v += G) {
        const int kind = v >> 7, bh = (v & 127) >> 3, s = v & 7;
        const BlockRef r0 = make_ref(a.ws, kind, bh >> 2, bh & 3, 15 - s), r1 = make_ref(a.ws, kind, bh >> 2, bh & 3, s);
        Seam S;
        attn_prime(r0, (LAS char*)lds, S);
        for (int pass = 0; pass < 2; ++pass) { const BlockRef cur = pass ? r1 : r0; attn_block(cur, r1, (LAS char*)lds, S); }
    }
}
#undef KSWZ
#undef SBAR
}

constexpr int NPHASE = 9;
__global__ void __launch_bounds__(NWAVES * 64, 2) mega_fwd(Args args) {
    extern __shared__ __attribute__((aligned(16))) unsigned char lds_raw[];
    LAS unsigned char* lds = (LAS unsigned char*)lds_raw;
    volatile LAS unsigned* MISC = (volatile LAS unsigned*)(lds + MISC_OFF);
    const int tid = threadIdx.x, lane = tid & 63, wave = __builtin_amdgcn_readfirstlane(tid >> 6);
    const int G = gridDim.x, bx = blockIdx.x, vcu = (G % 8 == 0) ? (bx % 8) * (G / 8) + bx / 8 : bx;
    unsigned char* ws = args.ws;
    if (tid < 16) MISC[tid] = 0u;
    __syncthreads();
    const int lo = args.ph_lo, hi = args.ph_hi;
    const bool multi = hi - lo > 1;
    XcdBarrier bar; bar.bar = (unsigned*)(ws + WS_CTL) + 1024 + args.li * XCD_BAR_WORDS; bar.x = 0; bar.st = nullptr;
    if (multi) bar = xcd_barrier_post((unsigned*)(ws + WS_CTL) + 1024 + args.li * XCD_BAR_WORDS, MISC + 8);
#define IN(k) (lo <= (k) && (k) < hi)
    bool fast = false;
#define SEAM_LOCAL(k) ((k) == 1 || (k) == 5 || (k) == 6 || (k) == 7)
#define SEAM(k) do { if (IN(k) && IN((k) + 1)) { if (fast && SEAM_LOCAL(k)) xcd_local_barrier(bar); else xcd_barrier(bar); } } while (0)
    if (IN(0)) { p0_prologue(args, lds, vcu, G, tid, lane, wave); SEAM(0);
        if (lo == 0 && hi == NPHASE && G == 256) {     if (tid == 0) MISC[12] = xb_ld(&bar.bar[XB_MIS]) == 0u ? 1u : 0u; __syncthreads(); fast = MISC[12] != 0u; } }
    if (IN(1)) { p1_hn(args, vcu, G, lane, wave); SEAM(1); }
    if (IN(2)) {
        pg8::Gemm g{(const h16*)(ws + WS_HN), (const h16*)(ws + WS_HN), (const h16*)(ws + WS_WIN), (const h16*)(ws + WS_WIN), 1024};
        pg8::StaticOrder S; S.init(T_, NIN, G, bx);
        EpiInProj E{args.flags & 1, ws, (h16*)args.out};
        fill_rope_deltas(ws, lds + SCR_OFF, tid);
        pg8::gemm_phase(lds, g, S, E); SEAM(2);
    }
    if (IN(3)) { idxp::p3_index(args, lds, vcu, G, tid, lane, wave); SEAM(3); }
    if (IN(4)) { p5_bias2(args, vcu, G, lane, wave); attp::p4_attention(args, lds, vcu, G); SEAM(4); }
    if (IN(5)) {
        pg8::Gemm g{(const h16*)(ws + WS_QI), (const h16*)(ws + WS_QBL), (const h16*)(ws + WS_WA), (const h16*)(ws + WS_WB), 512};
        pg8::StaticOrder S; S.init(T_, 1024, G, bx, 2);
        EpiBranch E{(const h16*)args.out, (const h16*)args.out + (size_t)T_ * 1024, (h16*)(ws + WS_HN)};
        pg8::gemm_phase(lds, g, S, E);
        if (fast) { asm volatile("s_waitcnt vmcnt(0)" ::: "memory"); __syncthreads(); if (tid == 0) (void)xb_add(&bar.bar[XB_P5D], 1u); }
        SEAM(5);
    }
    if (IN(6)) {
        pg8::Gemm g{(const h16*)(ws + WS_HN), (const h16*)(ws + WS_HN), (const h16*)(ws + WS_WOUT), (const h16*)(ws + WS_WOUT), 1024};
        pg8::StaticOrder S; S.init(T_, 1024, G, bx);
        EpiOut E{args.x, args.g_ffn, (const float*)(ws + WS_MOD), ws, (h16*)(ws + WS_A2), (float*)(ws + WS_SSQ)};
        pg8::gemm_phase(lds, g, S, E); SEAM(6);
    }
    if (IN(7)) {
        pg8::Gemm g{(const h16*)(ws + WS_A2), (const h16*)(ws + WS_A2), (const h16*)(ws + WS_WGU), (const h16*)(ws + WS_WGU), 1024};
        pg8::StaticOrder S; S.init(T_, NGU, G, bx);
        const bool tail = G == 256;
        if (tail) S.cap = 5 * 256;
        EpiGUT<2> E{args.flags & 1, (const float*)(ws + WS_SSQ), (const float*)(ws + WS_BIAS2), (h16*)(ws + WS_ACT)};
        pg8::gemm_phase(lds, g, S, E);
        if (tail) {
            pg8::Gemm gh{(const h16*)(ws + WS_A2), (const h16*)(ws + WS_A2) + (size_t)128 * 1024, (const h16*)(ws + WS_WGU), (const h16*)(ws + WS_WGU), 1024};
            pg8::HalfTail H{S, bx};
            EpiGUT<1> Eh{args.flags & 1, (const float*)(ws + WS_SSQ), (const float*)(ws + WS_BIAS2), (h16*)(ws + WS_ACT)};
            pg8::gemm_phase<EpiGUT<1>, pg8::HalfTail, true>(lds, gh, H, Eh);
        }
        SEAM(7);
    }
    if (IN(8)) {
        if (fast) { if (tid == 0) XB_SPIN(xb_ld(&bar.bar[XB_P5D]) < (unsigned)G, bar.bar); __syncthreads(); }
        pg8::Gemm g{(const h16*)(ws + WS_ACT), (const h16*)(ws + WS_ACT), (const h16*)(ws + WS_WDN), (const h16*)(ws + WS_WDN), DFF};
        pg8::StaticOrder S; S.init(T_, 1024, G, bx);
        EpiDown E{(const float*)(ws + WS_MOD), ws, args.out};
        pg8::gemm_phase(lds, g, S, E);
    }
#undef IN
#undef SEAM
}


extern "C" void kernel_launch(void* const* d_in, const int* in_sizes, int n_in, void* d_out, int out_size, void* d_ws, size_t ws_size, hipStream_t stream) {
    static int grid = 0;
    if (grid == 0) {
        int dev = 0, cus = 0;
        if (hipGetDevice(&dev) != hipSuccess || hipDeviceGetAttribute(&cus, hipDeviceAttributeMultiprocessorCount, dev) != hipSuccess) { fprintf(stderr, "kernel_launch: device query failed\n"); grid = -1; return; }
        if (hipFuncSetAttribute((const void*)mega_fwd, hipFuncAttributeMaxDynamicSharedMemorySize, LDS_BYTES) != hipSuccess) { fprintf(stderr, "kernel_launch: hipFuncSetAttribute failed\n"); grid = -1; return; }
        (void)hipGetLastError();
        grid = cus;
        if (ws_size < 256 * MiB) { fprintf(stderr, "kernel_launch: workspace too small\n"); grid = -1; return; }
    }
    if (grid < 0) return;
    const float* x = (const float*)d_in[0]; const float* c = (const float*)d_in[1]; const float* w_mod = (const float*)d_in[2]; const float* b_mod = (const float*)d_in[3];
    const float* g_mix = (const float*)d_in[4]; const float* g_ffn = (const float*)d_in[5]; const float* w_in = (const float*)d_in[6];
    const float* g_q_dsa = (const float*)d_in[7]; const float* g_k_dsa = (const float*)d_in[8]; const float* g_q_moba = (const float*)d_in[9]; const float* g_k_moba = (const float*)d_in[10];
    const float* w_br_dsa = (const float*)d_in[11]; const float* w_br_moba = (const float*)d_in[12]; const float* w_out = (const float*)d_in[13];
    const float* w_gate_up = (const float*)d_in[14]; const float* w_down = (const float*)d_in[15];
    unsigned char* ws = (unsigned char*)d_ws; float* out = (float*)d_out;

    if (hipMemsetAsync((char*)d_ws + WS_CTL, 0, CTL_ZERO_BYTES, stream) != hipSuccess) { fprintf(stderr, "kernel_launch: memset failed\n"); return; }
    Args a{};
    a.x = x; a.c = c; a.w_mod = w_mod; a.b_mod = b_mod; a.g_mix = g_mix; a.g_ffn = g_ffn; a.w_in = w_in; a.g_q_dsa = g_q_dsa; a.g_k_dsa = g_k_dsa; a.g_q_moba = g_q_moba; a.g_k_moba = g_k_moba;
    a.w_br_dsa = w_br_dsa; a.w_br_moba = w_br_moba; a.w_out = w_out; a.w_gate_up = w_gate_up; a.w_down = w_down; a.out = out; a.ws = ws;
#define MEGA(lo_, hi_) do { a.ph_lo = (lo_); a.ph_hi = (hi_); hipLaunchKernelGGL(mega_fwd, dim3(grid), dim3(NWAVES * 64), LDS_BYTES, stream, a); } while (0)
    MEGA(0, NPHASE);

}
```

```cpp
#include <hip/hip_runtime.h>
#include <cstdint>
#include <cstdio>
typedef _Float16 h16;
typedef unsigned long long u64;

constexpr int NB = 4, S_ = 4096, D_ = 1024, T_ = NB * S_, HD = 128, NH = 4, IH = 8, ID = 64, TOPK = 256, MBLK = 256, NBLK = 16;
constexpr int DFF = 2816, INW = 5704, HW = 512;
constexpr float EPS = 1e-6f;
constexpr int C_QA = 0, C_KA = 512, C_VA = 1024, C_QI = 1536, C_KI = 2048, C_WI = 2112, C_QB = 2120, C_KB = 2632, C_VB = 3144, C_GA = 3656, C_GB = 4680;
constexpr int NIN = 5888;
constexpr int NGU = 2 * DFF;

constexpr size_t KiB = 1024, MiB = 1u << 20;
constexpr size_t WS_CTL = 0, CTL_ZERO_BYTES = 64 * KiB;
constexpr size_t WS_MOD = 1 * MiB;
constexpr size_t WS_KMEAN = 1 * MiB + 256 * KiB;
constexpr size_t WS_M16 = 1 * MiB + 512 * KiB;
constexpr size_t WS_BIAS2 = 1 * MiB + 768 * KiB;
constexpr size_t WS_GAINS = 1 * MiB + 896 * KiB;
constexpr size_t WS_WI = 2 * MiB;
constexpr size_t WS_SSQ = 2 * MiB + 512 * KiB;
constexpr size_t WS_KI = 3 * MiB + 512 * KiB;
constexpr size_t WS_MASK = 5 * MiB + 512 * KiB;
constexpr size_t WS_COS128 = 13 * MiB + 512 * KiB, WS_SIN128 = WS_COS128 + MiB, WS_COS64 = WS_SIN128 + MiB, WS_SIN64 = WS_COS64 + 512 * KiB;
constexpr size_t WS_WIN = 16 * MiB + 512 * KiB;
constexpr size_t WS_WA = WS_WIN + (size_t)NIN * 1024 * 2, WS_WB = WS_WA + MiB, WS_WOUT = WS_WB + MiB;
constexpr size_t WS_WGU = WS_WOUT + 2 * MiB;
constexpr size_t WS_WDN = WS_WGU + (size_t)NGU * 1024 * 2;
constexpr size_t WS_HN = 48 * MiB + 512 * KiB;
constexpr size_t WS_MASKB = WS_HN;
constexpr size_t WS_QA = 80 * MiB + 512 * KiB, WS_KA = WS_QA + 16 * MiB, WS_VA = WS_KA + 16 * MiB, WS_KB = WS_VA + 16 * MiB, WS_VB = WS_KB + 16 * MiB;
constexpr size_t WS_QB = WS_VB + 16 * MiB, WS_QI = WS_QB + 16 * MiB, WS_QBL = WS_QI + 16 * MiB;
constexpr size_t WS_A2 = WS_QBL + 16 * MiB;
constexpr int X1H_SPLIT = 44;
constexpr size_t WS_X1HA = WS_MASK, WS_X1HB = WS_A2 + 32 * MiB;
static_assert(WS_X1HA + (size_t)X1H_SPLIT * 256 * 2048 <= WS_WA && WS_X1HB + (size_t)(64 - X1H_SPLIT) * 256 * 2048 <= 256 * MiB, "x1 pieces fit");
constexpr size_t WS_ACT = WS_QA;
constexpr size_t WS_TMP = WS_A2;
constexpr size_t WS_TMP2 = WS_QA;
static_assert(WS_WDN + (size_t)1024 * DFF * 2 <= WS_HN, "weights fit");
static_assert(WS_A2 + 32 * MiB <= 256 * MiB, "ws fits");

__device__ __forceinline__ float sigmoidf_(float v) { return 1.f / (1.f + __expf(-v)); }

#define ONE_LAUNCH 1
__global__ void __launch_bounds__(256) mod_naive(const float* c, const float* w_mod, const float* b_mod, float* MOD) {
    const int n = blockIdx.x * 256 + threadIdx.x;
    float a0 = 0, a1 = 0, a2 = 0, a3 = 0;
    for (int k = 0; k < D_; ++k) {
        const float w = w_mod[(size_t)k * 6144 + n];
        float c0 = c[k], c1 = c[D_ + k], c2 = c[2 * D_ + k], c3 = c[3 * D_ + k];
        a0 += c0 / (1.f + expf(-c0)) * w; a1 += c1 / (1.f + expf(-c1)) * w; a2 += c2 / (1.f + expf(-c2)) * w; a3 += c3 / (1.f + expf(-c3)) * w;
    }
    const float bb = b_mod[n];
    MOD[n] = a0 + bb; MOD[6144 + n] = a1 + bb; MOD[2 * 6144 + n] = a2 + bb; MOD[3 * 6144 + n] = a3 + bb;
}

__global__ void __launch_bounds__(256) normmod_naive(const float* x, const float* g, const float* MOD, int sh_off, int sc_off, h16* out) {
    const int row = blockIdx.x, b = row / S_, tid = threadIdx.x;
    __shared__ float red[256];
    const float* xr = x + (size_t)row * D_;
    float v[4]; float s = 0;
#pragma unroll
    for (int j = 0; j < 4; ++j) { v[j] = xr[tid + 256 * j]; s += v[j] * v[j]; }
    red[tid] = s; __syncthreads();
    for (int o = 128; o > 0; o >>= 1) { if (tid < o) red[tid] += red[tid + o]; __syncthreads(); }
    const float r = rsqrtf(red[0] / D_ + EPS);
#pragma unroll
    for (int j = 0; j < 4; ++j) { const int k = tid + 256 * j; const float sc = MOD[b * 6144 + sc_off + k], sh = MOD[b * 6144 + sh_off + k];
        out[(size_t)row * D_ + k] = (h16)(v[j] * r * g[k] * (1.f + sc) + sh); }
}

struct EpiF32 { float* out; int ldc; int pad; __device__ void operator()(int r, int c, float a, float) const { out[(size_t)r * ldc + c] = a; } };
struct EpiSigH { h16* out; int ldc; int pad; __device__ void operator()(int r, int c, float a, float) const { out[(size_t)r * ldc + c] = (h16)sigmoidf_(a); } };
struct EpiH { h16* out; int ldc; int pad; __device__ void operator()(int r, int c, float a, float) const { out[(size_t)r * ldc + c] = (h16)a; } };
struct EpiGateF32 { const h16* gate; float* out; int accum; int pad; __device__ void operator()(int r, int c, float a, float) const {
    const float v = (float)gate[(size_t)r * D_ + c] * a; float* p = out + (size_t)r * D_ + c; *p = accum ? *p + v : v; } };
struct EpiGateH { const h16* gate; const float* part; h16* out; __device__ void operator()(int r, int c, float a, float) const {
    const float v = (float)gate[(size_t)r * D_ + c] * a + part[(size_t)r * D_ + c]; out[(size_t)r * D_ + c] = (h16)v; } };
struct EpiRes { const float* base; const float* MOD; float* out; int gt_off; int pad; __device__ void operator()(int r, int c, float a, float) const {
    const int b = r / S_; out[(size_t)r * D_ + c] = base[(size_t)r * D_ + c] + MOD[b * 6144 + gt_off + c] * a; } };
struct EpiSwiglu { h16* out; __device__ void operator()(int r, int c, float g, float u) const { out[(size_t)r * DFF + c] = (h16)(g / (1.f + __expf(-g)) * u); } };

template <bool DUAL, class Epi>
__global__ void __launch_bounds__(256) gemm_naive(const h16* A, int lda, const float* W, int ldb, int col0, int col1off, int N, int K, Epi E) {
    __shared__ float As[16][65]; __shared__ float Bs[16][64]; __shared__ float Bs2[DUAL ? 16 : 1][64];
    const int tid = threadIdx.x, tx = tid % 16, ty = tid / 16, m0 = blockIdx.y * 64, n0 = blockIdx.x * 64;
    float acc[4][4], acc2[4][4];
#pragma unroll
    for (int i = 0; i < 4; ++i)
#pragma unroll
        for (int j = 0; j < 4; ++j) { acc[i][j] = 0.f; acc2[i][j] = 0.f; }
    for (int k0 = 0; k0 < K; k0 += 16) {
#pragma unroll
        for (int i = 0; i < 4; ++i) { const int e = tid + 256 * i, r = e / 16, cc = e % 16; As[cc][r] = (float)A[(size_t)(m0 + r) * lda + k0 + cc]; }
#pragma unroll
        for (int i = 0; i < 4; ++i) { const int e = tid + 256 * i, r = e / 64, cc = e % 64, n = n0 + cc;
            Bs[r][cc] = n < N ? W[(size_t)(k0 + r) * ldb + col0 + n] : 0.f;
            if (DUAL) Bs2[r][cc] = n < N ? W[(size_t)(k0 + r) * ldb + col0 + col1off + n] : 0.f; }
        __syncthreads();
#pragma unroll
        for (int k = 0; k < 16; ++k) {
            float a[4], bb[4], b2[4];
#pragma unroll
            for (int i = 0; i < 4; ++i) { a[i] = As[k][ty * 4 + i]; bb[i] = Bs[k][tx * 4 + i]; b2[i] = DUAL ? Bs2[k][tx * 4 + i] : 0.f; }
#pragma unroll
            for (int i = 0; i < 4; ++i)
#pragma unroll
                for (int j = 0; j < 4; ++j) { acc[i][j] += a[i] * bb[j]; if (DUAL) acc2[i][j] += a[i] * b2[j]; }
        }
        __syncthreads();
    }
#pragma unroll
    for (int i = 0; i < 4; ++i)
#pragma unroll
        for (int j = 0; j < 4; ++j) { const int r = m0 + ty * 4 + i, cc = n0 + tx * 4 + j; if (cc < N) E(r, cc, acc[i][j], acc2[i][j]); }
}

__global__ void __launch_bounds__(256) heads_post_naive(float* TMP, int ld, const float* gain, int nheads, int hd, h16* out, int ldo, h16* out_lo, int writeback) {
    const int row = blockIdx.x, t = row % S_, tid = threadIdx.x, half = hd / 2, h = tid / half, i = tid % half;
    __shared__ float sq[256];
    float x1 = 0, x2 = 0;
    if (h < nheads) { x1 = TMP[(size_t)row * ld + h * hd + i]; x2 = TMP[(size_t)row * ld + h * hd + i + half]; }
    sq[tid] = x1 * x1 + x2 * x2; __syncthreads();
    if (h < nheads) {
        if (gain) { float s = 0; for (int j = 0; j < half; ++j) s += sq[h * half + j]; const float r = rsqrtf(s / hd + EPS); x1 = x1 * r * gain[i]; x2 = x2 * r * gain[i + half]; }
        const float inv = (float)pow(10000.0, -(double)(2 * i) / (double)hd); const float ang = (float)t * inv;
        const float cs = (float)cos((double)ang), sn = (float)sin((double)ang);
        const float o1 = x1 * cs - x2 * sn, o2 = x2 * cs + x1 * sn;
        const h16 h1 = (h16)o1, h2 = (h16)o2;
        out[(size_t)row * ldo + h * hd + i] = h1; out[(size_t)row * ldo + h * hd + i + half] = h2;
        if (out_lo) { out_lo[(size_t)row * ldo + h * hd + i] = (h16)(o1 - (float)h1); out_lo[(size_t)row * ldo + h * hd + i + half] = (h16)(o2 - (float)h2); }
        if (writeback) { TMP[(size_t)row * ld + h * hd + i] = o1; TMP[(size_t)row * ld + h * hd + i + half] = o2; }
    }
}
__global__ void __launch_bounds__(256) cvt_naive(const float* TMP, h16* out, size_t n) { const size_t i = (size_t)blockIdx.x * 256 + threadIdx.x; if (i < n) out[i] = (h16)TMP[i]; }
__global__ void __launch_bounds__(64) kiwi_post_naive(const float* TMP, h16* KI, float* WI) {
    const int row = blockIdx.x, t = row % S_, tid = threadIdx.x;
    if (tid < 32) { const int i = tid; const float x1 = TMP[(size_t)row * 72 + i], x2 = TMP[(size_t)row * 72 + i + 32];
        const float inv = (float)pow(10000.0, -(double)(2 * i) / 64.0); const float ang = (float)t * inv; const float cs = (float)cos((double)ang), sn = (float)sin((double)ang);
        KI[(size_t)row * 64 + i] = (h16)(x1 * cs - x2 * sn); KI[(size_t)row * 64 + i + 32] = (h16)(x2 * cs + x1 * sn); }
    else if (tid < 40) { const float scale = 0.35355339059327373f * 0.125f; WI[(size_t)row * 8 + tid - 32] = TMP[(size_t)row * 72 + 64 + tid - 32] * scale; }
}
__global__ void __launch_bounds__(128) kmean_naive(const float* TMP, float* KMEAN) {
    const int blk = blockIdx.x % NBLK, h = (blockIdx.x / NBLK) % NH, b = blockIdx.x / (NBLK * NH), d = threadIdx.x;
    float s = 0; for (int r = 0; r < MBLK; ++r) s += TMP[(size_t)(b * S_ + blk * MBLK + r) * HW + h * HD + d];
    KMEAN[((size_t)(b * NH + h) * NBLK + blk) * HD + d] = s * (1.f / MBLK);
}
__device__ __forceinline__ unsigned fkey(float f) { const unsigned u = __float_as_uint(f); return (u & 0x80000000u) ? ~u : (u | 0x80000000u); }
__global__ void __launch_bounds__(256) idx_topk_naive(const h16* QI, const h16* KI, const float* WI, u64* MASK) {
    const int row = blockIdx.x, b = row / S_, t = row % S_, tid = threadIdx.x;
    __shared__ float q[512]; __shared__ float w[8]; __shared__ unsigned key[4096]; __shared__ int cnt; __shared__ u64 mw[64];
    q[tid] = (float)QI[(size_t)row * 512 + tid]; q[tid + 256] = (float)QI[(size_t)row * 512 + tid + 256];
    if (tid < 8) w[tid] = WI[(size_t)row * 8 + tid];
    if (tid < 64) mw[tid] = 0ull;
    __syncthreads();
    for (int s = tid; s < S_; s += 256) {
        unsigned kk = 0u;
        if (s <= t) { const h16* kr = KI + (size_t)(b * S_ + s) * 64; float sc = 0.f;
            for (int h = 0; h < 8; ++h) { float d = 0.f; for (int e = 0; e < 64; ++e) d += q[h * 64 + e] * (float)kr[e]; sc += w[h] * fmaxf(d, 0.f); }
            kk = fkey(sc); }
        key[s] = kk;
    }
    __syncthreads();
    const int N = t + 1;
    if (N <= TOPK) { for (int s = tid; s < N; s += 256) atomicOr(&mw[s >> 6], 1ull << (s & 63)); }
    else {
        unsigned Tk = 0u;
        for (int bit = 31; bit >= 0; --bit) {
            const unsigned cand = Tk | (1u << bit);
            if (tid == 0) cnt = 0; __syncthreads();
            int c = 0; for (int s = tid; s < S_; s += 256) c += (key[s] >= cand);
            atomicAdd(&cnt, c); __syncthreads();
            if (cnt >= TOPK) Tk = cand; __syncthreads();
        }
        if (tid == 0) cnt = 0; __syncthreads();
        { int c = 0; for (int s = tid; s < S_; s += 256) c += (key[s] > Tk); atomicAdd(&cnt, c); } __syncthreads();
        const int need = TOPK - cnt;
        for (int s = tid; s < S_; s += 256) {
            const unsigned kk = key[s]; bool sel = kk > Tk;
            if (kk == Tk) { int lower = 0; for (int s2 = 0; s2 < s; ++s2) lower += (key[s2] == Tk); sel = lower < need; }
            if (sel) atomicOr(&mw[s >> 6], 1ull << (s & 63));
        }
    }
    __syncthreads();
    if (tid < 64) MASK[((size_t)b * 64 + tid) * S_ + t] = mw[tid];
}
__global__ void __launch_bounds__(256) moba_sel_naive(const h16* QB, const h16* QBL, const float* KMEAN, unsigned* M16) {
    const int idx = blockIdx.x * 256 + threadIdx.x; const int t = idx % S_, h = (idx / S_) % NH, b = idx / (S_ * NH);
    const int own = t / MBLK; const size_t qo = (size_t)(b * S_ + t) * HW + h * HD;
    float v1 = -3e38f, v2 = -3e38f, v3 = -3e38f; int i1 = -1, i2 = -1, i3 = -1;
    for (int j = 0; j < own; ++j) { const float* km = KMEAN + ((size_t)(b * NH + h) * NBLK + j) * HD; float g = 0.f;
        for (int d = 0; d < HD; ++d) g += ((float)QB[qo + d] + (float)QBL[qo + d]) * km[d];
        if (g > v1) { v3 = v2; i3 = i2; v2 = v1; i2 = i1; v1 = g; i1 = j; } else if (g > v2) { v3 = v2; i3 = i2; v2 = g; i2 = j; } else if (g > v3) { v3 = g; i3 = j; } }
    unsigned m = 1u << own; if (i1 >= 0) m |= 1u << i1; if (i2 >= 0) m |= 1u << i2; if (i3 >= 0) m |= 1u << i3;
    M16[idx] = m;
}
__global__ void __launch_bounds__(256) dsa_attn_naive(const h16* QA, const h16* KA, const h16* VA, const u64* MASK, h16* OA) {
    const int row = blockIdx.x, b = row / S_, t = row % S_, tid = threadIdx.x;
    __shared__ int sel[256]; __shared__ int off[65]; __shared__ u64 wd[64]; __shared__ float p[4][256]; __shared__ float qs[512];
    qs[tid] = (float)QA[(size_t)row * HW + tid]; qs[tid + 256] = (float)QA[(size_t)row * HW + tid + 256];
    if (tid < 64) wd[tid] = (tid <= (t >> 6)) ? MASK[((size_t)b * 64 + tid) * S_ + t] : 0ull;
    __syncthreads();
    if (tid == 0) { int o = 0; for (int i = 0; i < 64; ++i) { off[i] = o; o += __popcll(wd[i]); } off[64] = o; }
    __syncthreads();
    if (tid < 64) { u64 m = wd[tid]; int o = off[tid]; while (m) { const int bpos = __ffsll((long long)m) - 1; m &= m - 1; if (o < 256) sel[o] = tid * 64 + bpos; ++o; } }
    __syncthreads();
    const int ns = off[64] < 256 ? off[64] : 256;
    const float scale = 0.08838834764831845f;
    for (int e = tid; e < 4 * ns; e += 256) { const int h = e & 3, k = e >> 2; const h16* kr = KA + (size_t)(b * S_ + sel[k]) * HW + h * HD; float d = 0.f;
        for (int j = 0; j < HD; ++j) d += qs[h * HD + j] * (float)kr[j]; p[h][k] = d * scale; }
    __syncthreads();
    if (tid < 4) { float m = -3e38f; for (int k = 0; k < ns; ++k) m = fmaxf(m, p[tid][k]); float s = 0.f; for (int k = 0; k < ns; ++k) { const float e = expf(p[tid][k] - m); p[tid][k] = e; s += e; }
        const float r = 1.f / s; for (int k = 0; k < ns; ++k) p[tid][k] *= r; }
    __syncthreads();
    { const int h = tid >> 6, d = (tid & 63) * 2; float a0 = 0.f, a1 = 0.f;
      for (int k = 0; k < ns; ++k) { const h16* vr = VA + (size_t)(b * S_ + sel[k]) * HW + h * HD + d; a0 += p[h][k] * (float)vr[0]; a1 += p[h][k] * (float)vr[1]; }
      OA[(size_t)row * HW + h * HD + d] = (h16)a0; OA[(size_t)row * HW + h * HD + d + 1] = (h16)a1; }
}
__global__ void __launch_bounds__(256) moba_attn_naive(const h16* QB, const h16* KB, const h16* VB, const unsigned* M16, h16* OB) {
    const int row = blockIdx.x, b = row / S_, t = row % S_, tid = threadIdx.x;
    __shared__ float sc[1024]; __shared__ int blks[4]; __shared__ float qs[128]; __shared__ float red[256]; __shared__ float part[256];
    const float scale = 0.08838834764831845f;
    for (int h = 0; h < NH; ++h) {
        const unsigned m = M16[(size_t)(b * NH + h) * S_ + t];
        if (tid < 128) qs[tid] = (float)QB[(size_t)row * HW + h * HD + tid];
        if (tid == 0) { int n = 0; for (int j = 0; j < NBLK; ++j) if ((m >> j) & 1u) { if (n < 4) blks[n] = j; ++n; } for (; n < 4; ++n) blks[n] = -1; }
        __syncthreads();
        float lm = -3e38f;
        for (int sl = 0; sl < 4; ++sl) { const int j = blks[sl]; float v = -3e38f;
            if (j >= 0) { const int s = j * MBLK + tid; if (s <= t) { const h16* kr = KB + (size_t)(b * S_ + s) * HW + h * HD; float d = 0.f; for (int e = 0; e < HD; ++e) d += qs[e] * (float)kr[e]; v = d * scale; } }
            sc[sl * 256 + tid] = v; lm = fmaxf(lm, v); }
        red[tid] = lm; __syncthreads();
        for (int o = 128; o > 0; o >>= 1) { if (tid < o) red[tid] = fmaxf(red[tid], red[tid + o]); __syncthreads(); }
        const float mx = red[0]; __syncthreads();
        float ls = 0.f;
        for (int sl = 0; sl < 4; ++sl) { const float v = sc[sl * 256 + tid]; const float e = v > -1e38f ? expf(v - mx) : 0.f; sc[sl * 256 + tid] = e; ls += e; }
        red[tid] = ls; __syncthreads();
        for (int o = 128; o > 0; o >>= 1) { if (tid < o) red[tid] += red[tid + o]; __syncthreads(); }
        const float rs = 1.f / red[0]; __syncthreads();
        { const int d = tid & 127, hf = tid >> 7; float a = 0.f;
          for (int sl = hf * 2; sl < hf * 2 + 2; ++sl) { const int j = blks[sl]; if (j >= 0) for (int k = 0; k < 256; ++k) { const float pp = sc[sl * 256 + k]; if (pp != 0.f) a += pp * (float)VB[(size_t)(b * S_ + j * MBLK + k) * HW + h * HD + d]; } }
          part[tid] = a; }
        __syncthreads();
        if (tid < 128) OB[(size_t)row * HW + h * HD + tid] = (h16)((part[tid] + part[tid + 128]) * rs);
        __syncthreads();
    }
}

#define LAS __attribute__((address_space(3)))
#define GAS __attribute__((address_space(1)))
typedef _Float16 f16x8 __attribute__((ext_vector_type(8)));
typedef _Float16 f16x4 __attribute__((ext_vector_type(4)));
typedef _Float16 f16x2 __attribute__((ext_vector_type(2)));
typedef float f32x4 __attribute__((ext_vector_type(4)));
typedef float f32x2 __attribute__((ext_vector_type(2)));
typedef unsigned u32x4 __attribute__((ext_vector_type(4)));
typedef unsigned u32x2 __attribute__((ext_vector_type(2)));

__device__ __forceinline__ unsigned pkh(float a, float b) { f16x2 v = {(h16)a, (h16)b}; return __builtin_bit_cast(unsigned, v); }
__device__ __forceinline__ u32x2 pkh4(f32x4 a) { u32x2 r; r.x = pkh(a[0], a[1]); r.y = pkh(a[2], a[3]); return r; }
__device__ __forceinline__ u32x4 pkh8(f32x4 a, f32x4 b) { u32x4 r; r.x = pkh(a[0], a[1]); r.y = pkh(a[2], a[3]); r.z = pkh(b[0], b[1]); r.w = pkh(b[2], b[3]); return r; }
__device__ __forceinline__ f32x4 unpk4(u32x2 w) { const f16x4 h = __builtin_bit_cast(f16x4, w); f32x4 r; r[0] = (float)h[0]; r[1] = (float)h[1]; r[2] = (float)h[2]; r[3] = (float)h[3]; return r; }
__device__ __forceinline__ void unpk8(u32x4 w, f32x4& lo, f32x4& hi) { const f16x8 h = __builtin_bit_cast(f16x8, w);
    lo[0] = (float)h[0]; lo[1] = (float)h[1]; lo[2] = (float)h[2]; lo[3] = (float)h[3]; hi[0] = (float)h[4]; hi[1] = (float)h[5]; hi[2] = (float)h[6]; hi[3] = (float)h[7]; }

namespace pg8 {
constexpr int BM = 256, BK = 64, HALF = 128, HTB = HALF * BK * 2  , STAGE_BYTES = 8 * HTB, NXCD = 8, WGM = 8;
__host__ __device__ __forceinline__ int lds_byte(int r, int c) { const int st = (r >> 4) * 2 + (c >> 5), rr = r & 15, cc = c & 31, ob = rr * 64 + cc * 2; return st * 1024 + (ob ^ (((ob >> 9) & 1) << 5)); }
__host__ __device__ __forceinline__ void stage_rc(int b, int& R, int& C) { const int st = b / 1024, sb = b % 1024, swz = sb ^ (((sb >> 9) & 1) << 5); R = (st >> 1) * 16 + swz / 64; C = (st & 1) * 32 + (swz % 64) / 2; }

struct Unit { int pm, pn, seg; };
struct Gemm { const h16* A0; const h16* A1; const h16* B0; const h16* B1; int K; };

struct StaticOrder {
    int nM, nN, nwg, G, c, nseg, cap;
    __device__ void init(int M, int N, int G_, int c_, int nseg_ = 1) { nM = M / BM; nN = N / BM; nwg = nM * nN; G = G_; c = c_; nseg = nseg_; cap = nwg; }
    __device__ void tile_of(int wgid_, Unit& u) const { int wgid = wgid_; { const int q = nwg / NXCD, r = nwg % NXCD, xcd = wgid % NXCD, off = wgid / NXCD; wgid = (xcd < r ? xcd * (q + 1) : r * (q + 1) + (xcd - r) * q) + off; }
        const int nig = WGM * nN, gid = wgid / nig, fm = gid * WGM, gsz = (nM - fm) < WGM ? (nM - fm) : WGM;
        u.pm = fm + ((wgid % nig) % gsz); u.pn = (wgid % nig) / gsz; }
    __device__ bool next(int i, Unit& u) const {
        const int it = i / nseg; u.seg = i % nseg;
        const long L = (long)it * G + c; if (L >= cap) return false;
        int wgid = (int)L; { const int q = nwg / NXCD, r = nwg % NXCD, xcd = wgid % NXCD, off = wgid / NXCD; wgid = (xcd < r ? xcd * (q + 1) : r * (q + 1) + (xcd - r) * q) + off; }
        const int nig = WGM * nN, gid = wgid / nig, fm = gid * WGM, gsz = (nM - fm) < WGM ? (nM - fm) : WGM;
        u.pm = fm + ((wgid % nig) % gsz); u.pn = (wgid % nig) / gsz; return true;
    }
};

struct HalfTail {
    StaticOrder S; int c;
    __device__ bool next(int i, Unit& u) const { if (i != 0) return false; S.tile_of(S.cap + 8 * (c >> 4) + (c & 7), u); u.seg = (c >> 3) & 1; return true; }
};

typedef f32x4 Acc[2][2][4][2];

template <class Epi, class Sched, bool HALFM = false>
__device__ __forceinline__ void gemm_phase(LAS unsigned char* lds, const Gemm g, const Sched& S, const Epi& E) {
    const int tid = threadIdx.x, wid = __builtin_amdgcn_readfirstlane(tid >> 6), lane = tid & 63, wr = wid >> 2, wc = wid & 3, fr = lane & 15, fq = lane >> 4;
    const int K = g.K, nt = K / BK;
    unsigned voffA[2];
#pragma unroll
    for (int i = 0; i < 2; ++i) { int R, C; stage_rc(tid * 16 + i * 8192, R, C); voffA[i] = (unsigned)(R * K + C) * 2u; }
    const size_t kstep = (size_t)(BK * 2);
    const size_t hstep = (size_t)HALF * K * 2;
    const size_t tstep = 2 * hstep;
    const unsigned ldsw = (unsigned)wid * 1024u;
    const int aoff = lds_byte(wr * 64 + fr, fq * 8), boff = lds_byte(wc * 32 + fr, fq * 8);
#define PG8_SA(b, h) (((b) * 2 + (h)) * HTB)
#define PG8_SB(b, h) ((4 + (b) * 2 + (h)) * HTB)
#define PG8_STAGE(bufoff, gbase) do { _Pragma("unroll") for (int _i = 0; _i < 2; ++_i) \
        __builtin_amdgcn_global_load_lds((const unsigned*)((const char*)(gbase) + voffA[_i]), (LAS unsigned*)(lds + (bufoff) + ldsw + _i * 8192), 16, 0, 0); } while (0)
#define PG8_LDA(dst, b, h) do { _Pragma("unroll") for (int m = 0; m < 4; ++m) _Pragma("unroll") for (int k = 0; k < 2; ++k) dst[m][k] = *(const LAS f16x8*)(lds + PG8_SA(b, h) + aoff + m * 2048 + k * 1024); } while (0)
#define PG8_LDB(dst, b, h) do { _Pragma("unroll") for (int n = 0; n < 2; ++n) _Pragma("unroll") for (int k = 0; k < 2; ++k) dst[n][k] = *(const LAS f16x8*)(lds + PG8_SB(b, h) + boff + n * 2048 + k * 1024); } while (0)
#define PG8_MMA(ai, bj, At, Bt) do { __builtin_amdgcn_s_setprio(1); _Pragma("unroll") for (int m = 0; m < 4; ++m) _Pragma("unroll") for (int n = 0; n < 2; ++n) _Pragma("unroll") for (int k = 0; k < 2; ++k) \
        acc[ai][bj][m][n] = __builtin_amdgcn_mfma_f32_16x16x32_f16(Bt[n][k], At[m][k], acc[ai][bj][m][n], 0, 0, 0); __builtin_amdgcn_s_setprio(0); } while (0)
#define PG8_WAIT_V(n) asm volatile("s_waitcnt vmcnt(" #n ")" ::: "memory")
#define PG8_WAIT_L(n) asm volatile("s_waitcnt lgkmcnt(" #n ")" ::: "memory")
#define PG8_BAR __builtin_amdgcn_s_barrier()
#define PG8_SCHED __builtin_amdgcn_sched_barrier(0)
#define PG8_ZERO() do { _Pragma("unroll") for (int a = 0; a < 2; ++a) _Pragma("unroll") for (int b = 0; b < 2; ++b) _Pragma("unroll") for (int m = 0; m < 4; ++m) _Pragma("unroll") for (int n = 0; n < 2; ++n) acc[a][b][m][n] = (f32x4){0.f, 0.f, 0.f, 0.f}; } while (0)
    Unit cur, nxt; int ui = 0;
    if (!S.next(0, cur)) return;
    Acc acc;
    PG8_ZERO();
    f16x8 At[4][2], B0[2][2], B1[2][2];
    const char* cA = (const char*)(cur.seg ? g.A1 : g.A0) + (size_t)cur.pm * tstep; const char* cB = (const char*)(cur.seg ? g.B1 : g.B0) + (size_t)cur.pn * tstep;
    PG8_STAGE(PG8_SB(0, 0), cB); PG8_STAGE(PG8_SB(0, 1), cB + hstep); PG8_STAGE(PG8_SA(0, 0), cA); if constexpr (!HALFM) PG8_STAGE(PG8_SA(0, 1), cA + hstep);
    if (wr == 1) PG8_BAR;
    if constexpr (HALFM) PG8_WAIT_V(0); else PG8_WAIT_V(2);
    PG8_BAR;
    PG8_STAGE(PG8_SB(1, 0), cB + kstep); PG8_STAGE(PG8_SA(1, 0), cA + kstep); PG8_STAGE(PG8_SB(1, 1), cB + hstep + kstep);
    PG8_WAIT_V(6); PG8_BAR;
    for (;;) {
        const bool has_next = S.next(ui + 1, nxt);
        const char* nA = has_next ? (const char*)(nxt.seg ? g.A1 : g.A0) + (size_t)nxt.pm * tstep : cA; const char* nB = has_next ? (const char*)(nxt.seg ? g.B1 : g.B0) + (size_t)nxt.pn * tstep : cB;
        for (int t = 0; t < nt; t += 2) {
            const bool last = (t == nt - 2);
            const char* a1 = cA + (size_t)(t + 1) * kstep;
            const char* a2 = last ? nA : cA + (size_t)(t + 2) * kstep; const char* b2 = last ? nB : cB + (size_t)(t + 2) * kstep;
            const char* a3 = a2 + kstep; const char* b3 = b2 + kstep;
            if constexpr (!HALFM) {
            PG8_LDB(B0, 0, 0); PG8_LDB(B1, 0, 1); PG8_SCHED; PG8_LDA(At, 0, 0); PG8_STAGE(PG8_SA(1, 1), a1 + hstep);
            PG8_WAIT_V(8); PG8_WAIT_L(0); PG8_BAR; PG8_MMA(0, 0, At, B0); PG8_MMA(0, 1, At, B1); PG8_BAR; PG8_SCHED;
            PG8_LDA(At, 0, 1); PG8_STAGE(PG8_SB(0, 0), b2); PG8_STAGE(PG8_SB(0, 1), b2 + hstep); PG8_STAGE(PG8_SA(0, 0), a2);
            PG8_WAIT_V(8); PG8_WAIT_L(0); PG8_BAR; PG8_MMA(1, 0, At, B0); PG8_MMA(1, 1, At, B1); PG8_BAR; PG8_SCHED;
            PG8_LDB(B0, 1, 0); PG8_LDB(B1, 1, 1); PG8_SCHED; PG8_LDA(At, 1, 0); PG8_STAGE(PG8_SA(0, 1), a2 + hstep);
            PG8_WAIT_V(8); PG8_WAIT_L(0); PG8_BAR; PG8_MMA(0, 0, At, B0); PG8_MMA(0, 1, At, B1); PG8_BAR; PG8_SCHED;
            PG8_LDA(At, 1, 1); PG8_STAGE(PG8_SB(1, 0), b3); PG8_STAGE(PG8_SB(1, 1), b3 + hstep); PG8_STAGE(PG8_SA(1, 0), a3);
            PG8_WAIT_V(8); PG8_WAIT_L(0); PG8_BAR; PG8_MMA(1, 0, At, B0); PG8_MMA(1, 1, At, B1); PG8_BAR; PG8_SCHED;
            } else {
            (void)a1;
            PG8_LDB(B0, 0, 0); PG8_LDB(B1, 0, 1); PG8_SCHED; PG8_LDA(At, 0, 0);
            PG8_WAIT_L(0); PG8_BAR; PG8_MMA(0, 0, At, B0); PG8_MMA(0, 1, At, B1); PG8_BAR; PG8_SCHED;
            PG8_STAGE(PG8_SB(0, 0), b2); PG8_STAGE(PG8_SB(0, 1), b2 + hstep); PG8_STAGE(PG8_SA(0, 0), a2);
            PG8_WAIT_V(6); PG8_BAR; PG8_BAR; PG8_SCHED;
            PG8_LDB(B0, 1, 0); PG8_LDB(B1, 1, 1); PG8_SCHED; PG8_LDA(At, 1, 0);
            PG8_WAIT_L(0); PG8_BAR; PG8_MMA(0, 0, At, B0); PG8_MMA(0, 1, At, B1); PG8_BAR; PG8_SCHED;
            PG8_STAGE(PG8_SB(1, 0), b3); PG8_STAGE(PG8_SB(1, 1), b3 + hstep); PG8_STAGE(PG8_SA(1, 0), a3);
            PG8_WAIT_V(6); PG8_BAR; PG8_BAR; PG8_SCHED;
            }
        }
        if (wr == 0) PG8_BAR;
        int fr_ = fr, fq_ = fq; asm volatile("" : "+v"(fr_), "+v"(fq_));
        const bool zero = E(acc, cur, nxt, has_next, ui, wr, wc, fr_, fq_, wid, fq_ * 16 + fr_, lds + STAGE_BYTES);
        if (!has_next) break;
        if (zero) PG8_ZERO();
        cur = nxt; cA = nA; cB = nB; ++ui;
        if (wr == 1) PG8_BAR;
    }
    PG8_WAIT_V(0);
    PG8_BAR;
#undef PG8_SA
#undef PG8_SB
#undef PG8_STAGE
#undef PG8_LDA
#undef PG8_LDB
#undef PG8_MMA
#undef PG8_ZERO
}
#define EPI_LWAIT_BAR() do { asm volatile("s_waitcnt lgkmcnt(0)" ::: "memory"); __builtin_amdgcn_s_barrier(); asm volatile("" ::: "memory"); } while (0)
}

constexpr int NWAVES = 8;
constexpr int RING_BYTES = 131072, SCR_OFF = RING_BYTES, LDS_BYTES = 155648, MISC_OFF = LDS_BYTES - 256;
constexpr int SCR_P = 0, SCR_KS = 4096, SCR_R = 6144, SCR_DT128 = 8192, SCR_DT64 = 12288;

typedef GAS unsigned gu32;
#define RLX_AGENT __ATOMIC_RELAXED, __HIP_MEMORY_SCOPE_AGENT
#define LDS_WAIT() asm volatile("s_waitcnt lgkmcnt(0)" ::: "memory")
#define VM_WAIT() asm volatile("s_waitcnt vmcnt(0)" ::: "memory")

#define XB_TMO      128
#define XB_XCNT(j)  (256  + 64 * (j))
#define XB_XSUB(j)  (1280 + 64 * (j))
#define XB_XGEN(j)  (2304 + 64 * (j))
#define XB_TOP      3328
#define XB_TOPGEN   3392
#define XCD_BAR_WORDS 3456
#define XB_CLS(k)  (129 + (k))
#define XB_MIS     140
#define XB_LSUB(j) (256 + 64 * (j) + 16)
#define XB_P5D     141
#define XB_SPIN_CAP (1u << 20)
__device__ __forceinline__ unsigned xb_ld(unsigned* p)              { return __hip_atomic_load(p, __ATOMIC_RELAXED, __HIP_MEMORY_SCOPE_AGENT); }
__device__ __forceinline__ unsigned xb_add(unsigned* p, unsigned v) { return __hip_atomic_fetch_add(p, v, __ATOMIC_RELAXED, __HIP_MEMORY_SCOPE_AGENT); }
__device__ __forceinline__ unsigned xb_xcc_id() { return (unsigned)__builtin_amdgcn_s_getreg((3 << 11) | 20) & 0xFu; }
#define XB_SPIN(cond, bar) do { unsigned _sp = 0; while (cond) { __builtin_amdgcn_s_sleep(1); \
    if ((++_sp & 255u) == 0u) { if (xb_ld(&(bar)[XB_TMO])) break; if (_sp > XB_SPIN_CAP) { atomicAdd(&(bar)[XB_TMO], 1u); break; } } } } while (0)
struct XcdBarrier { unsigned* bar; unsigned x; volatile LAS unsigned* st; };
__device__ __forceinline__ XcdBarrier xcd_barrier_post(unsigned* bar, volatile LAS unsigned* st) {
    XcdBarrier b; b.bar = bar; b.x = xb_xcc_id(); b.st = st;
    if (threadIdx.x == 0) { (void)xb_add(&bar[XB_XCNT(b.x)], 1u);
        unsigned seen = 0u; const unsigned want = b.x + 1u;
        if (!__hip_atomic_compare_exchange_strong(&bar[XB_CLS(blockIdx.x & 7u)], &seen, want, __ATOMIC_RELAXED, __ATOMIC_RELAXED, __HIP_MEMORY_SCOPE_AGENT) && seen != want) (void)xb_add(&bar[XB_MIS], 1u); }
    return b;
}
__device__ __forceinline__ void xcd_barrier_complete(unsigned* bar, unsigned x, unsigned& nloc, unsigned& nx) {
    const unsigned G = gridDim.x * gridDim.y * gridDim.z;
    unsigned sum, cnt, mine, sp = 0u;
    for (;;) {
        sum = 0u; cnt = 0u; mine = 0u;
#pragma unroll
        for (unsigned j = 0; j < 16; ++j) { const unsigned c = xb_ld(&bar[XB_XCNT(j)]); sum += c; cnt += (c > 0u) ? 1u : 0u; mine = (j == x) ? c : mine; }
        if (sum == G) break;
        __builtin_amdgcn_s_sleep(1);
        if ((++sp & 255u) == 0u) { if (xb_ld(&bar[XB_TMO])) break; if (sp > XB_SPIN_CAP) { atomicAdd(&bar[XB_TMO], 1u); break; } }
    }
    nloc = mine > 0u ? mine : 1u; nx = cnt > 0u ? cnt : 1u;
}
__device__ __forceinline__ void xcd_barrier(const XcdBarrier& b) {
    asm volatile("s_waitcnt vmcnt(0)" ::: "memory");
    __syncthreads();
    if (threadIdx.x == 0) {
        unsigned* bar = b.bar;
        __builtin_amdgcn_s_waitcnt(0);
        unsigned nloc = b.st[0], nx = b.st[1];
        if (nloc == 0u) { xcd_barrier_complete(bar, b.x, nloc, nx); b.st[0] = nloc; b.st[1] = nx; }
        const unsigned old = xb_add(&bar[XB_XSUB(b.x)], 1u);
        const unsigned gen = old / nloc;
        if (old + 1u == (gen + 1u) * nloc) {
            __builtin_amdgcn_fence(__ATOMIC_RELEASE, "agent");
            asm volatile("s_waitcnt vmcnt(0)" ::: "memory");
            const unsigned og = xb_add(&bar[XB_TOP], 1u);
            const unsigned tg = og / nx;
            if (og + 1u == (tg + 1u) * nx) xb_add(&bar[XB_TOPGEN], 1u);
            else XB_SPIN(xb_ld(&bar[XB_TOPGEN]) == tg, bar);
            xb_add(&bar[XB_XGEN(b.x)], 1u);
            __builtin_amdgcn_fence(__ATOMIC_ACQUIRE, "agent");
            asm volatile("s_waitcnt vmcnt(0)" ::: "memory");
        } else {
            XB_SPIN(xb_ld(&bar[XB_XGEN(b.x)]) == gen, bar);
            __builtin_amdgcn_fence(__ATOMIC_ACQUIRE, "agent");
            asm volatile("s_waitcnt vmcnt(0)" ::: "memory");
        }
    }
    __syncthreads();
}

__device__ __forceinline__ void xcd_local_barrier(const XcdBarrier& b, unsigned idx) {
    asm volatile("s_waitcnt vmcnt(0)" ::: "memory");
    __syncthreads();
    if (threadIdx.x == 0) {
        unsigned* bar = b.bar;
        __builtin_amdgcn_s_waitcnt(0);
        const unsigned nloc = b.st[0];
        (void)xb_add(&bar[XB_LSUB(b.x)], 1u);
        const unsigned tgt = (idx + 1u) * nloc;
        XB_SPIN(xb_ld(&bar[XB_LSUB(b.x)]) < tgt, bar);
        __builtin_amdgcn_fence(__ATOMIC_ACQUIRE, "agent");
        asm volatile("s_waitcnt vmcnt(0)" ::: "memory");
    }
    __syncthreads();
}

struct Args {
    const float *x, *c, *w_mod, *b_mod, *g_mix, *g_ffn, *w_in, *g_q_dsa, *g_k_dsa, *g_q_moba, *g_k_moba, *w_br_dsa, *w_br_moba, *w_out, *w_gate_up, *w_down;
    float* out; unsigned char* ws; int ph_lo, ph_hi, li, flags;
};

__device__ __forceinline__ float wave_sum(float v) {
#pragma unroll
    for (int o = 1; o < 64; o <<= 1) v += __shfl_xor(v, o);
    return v;
}

__device__ __forceinline__ int lc_plain8(int x) { const int bj = x >> 7, wc = (x >> 5) & 3, n = (x >> 4) & 1, fq = (x >> 2) & 3, j = x & 3; return 128 * bj + 32 * wc + 8 * fq + 4 * n + j; }
__device__ __forceinline__ int lc_rope128(int x) { const int bj = x >> 7, wc = (x >> 5) & 3, n = (x >> 4) & 1, fq = (x >> 2) & 3, j = x & 3; return 128 * (wc >> 1) + 64 * bj + 32 * (wc & 1) + 8 * fq + 4 * n + j; }
__device__ __forceinline__ int lc_rope64(int x) { const int bj = x >> 7, wc = (x >> 5) & 3, n = (x >> 4) & 1, fq = (x >> 2) & 3, j = x & 3; return 64 * wc + 32 * bj + 8 * fq + 4 * n + j; }
__device__ __forceinline__ int in_tile_type(int pn) { return pn == 22 ? 3 : (pn == 6 || pn == 7) ? 2 : ((pn >= 4 && pn <= 5) || pn >= 12) ? 1 : 0; }
__device__ __forceinline__ int in_tile_src(int pn) {
    return pn < 2 ? C_QA + 256 * pn : pn < 4 ? C_KA + 256 * (pn - 2) : pn < 6 ? C_VA + 256 * (pn - 4) : pn < 8 ? C_QI + 256 * (pn - 6) : pn < 10 ? C_QB + 256 * (pn - 8)
         : pn < 12 ? C_KB + 256 * (pn - 10) : pn < 14 ? C_VB + 256 * (pn - 12) : pn < 18 ? C_GA + 256 * (pn - 14) : C_GB + 256 * (pn - 18);
}
struct MapIn { __device__ __forceinline__ int operator()(int cp) const { const int pn = cp >> 8, x = cp & 255, ty = in_tile_type(pn);
    if (ty == 3) { const int bj = x >> 7, wc = (x >> 5) & 3, n = (x >> 4) & 1, fq = (x >> 2) & 3, j = x & 3; if (wc == 0) return C_KI + 32 * bj + 8 * fq + 4 * n + j; if (wc == 1 && bj == 0 && fq == 0) return C_WI + 4 * n + j; return -1; }
    return in_tile_src(pn) + (ty == 0 ? lc_rope128(x) : ty == 1 ? lc_plain8(x) : lc_rope64(x)); } };
struct MapPlain { __device__ __forceinline__ int operator()(int cp) const { return (cp & ~255) + lc_plain8(cp & 255); } };
struct MapGU { __device__ __forceinline__ int operator()(int cp) const { const int pn = cp >> 8, x = cp & 255, bj = x >> 7, wc = (x >> 5) & 3, n = (x >> 4) & 1, fq = (x >> 2) & 3, j = x & 3;
    return n * DFF + 128 * pn + 64 * bj + 16 * wc + 4 * fq + j; } };

template <class Map>
__device__ __forceinline__ void cvt_item(const float* W, int ldw, int K, h16* WT, int ngrp, int item, Map map, LAS float* scr, int lane) {
    const int kb = item / ngrp, grp = item % ngrp, k0 = 64 * kb, c0 = 32 * grp;
    const int src = map(c0 + (lane & 31));
    float v[32];
    const float* wp = W + (size_t)(k0 + (lane >> 5)) * ldw + (src >= 0 ? src : 0);
#pragma unroll
    for (int i = 0; i < 32; ++i) v[i] = wp[(size_t)(2 * i) * ldw];
#pragma unroll
    for (int i = 0; i < 32; ++i) scr[(2 * i + (lane >> 5)) * 33 + (lane & 31)] = src >= 0 ? v[i] : 0.f;
    LDS_WAIT(); asm volatile("" ::: "memory");
    const int c = lane & 7;
#pragma unroll
    for (int j = 0; j < 4; ++j) { const int n = (lane >> 3) + 8 * j; const LAS float* s = scr + (8 * c) * 33 + n;
        u32x4 o; o.x = pkh(s[0 * 33], s[1 * 33]); o.y = pkh(s[2 * 33], s[3 * 33]); o.z = pkh(s[4 * 33], s[5 * 33]); o.w = pkh(s[6 * 33], s[7 * 33]);
        *(GAS u32x4*)(WT + (size_t)(c0 + n) * K + k0 + 8 * c) = o; }
    LDS_WAIT(); asm volatile("" ::: "memory");
}

__device__ __forceinline__ void p0_prologue(const Args& a, LAS unsigned char* lds, int vcu, int G, int tid, int lane, int wave) {
    unsigned char* ws = a.ws;
    { LAS float* sc = (LAS float*)lds; LAS float* part = (LAS float*)(lds + 16384); float* MOD = (float*)(ws + WS_MOD);
      for (int m = vcu; m < 96; m += G) {
        for (int i = tid; i < 4096; i += 512) { const float v = a.c[i]; sc[i] = v / (1.f + expf(-v)); }
        __syncthreads();
        const int col = 64 * m + lane; float a0 = 0.f, a1 = 0.f, a2 = 0.f, a3 = 0.f;
#pragma unroll 1
        for (int k0 = 128 * wave; k0 < 128 * wave + 128; k0 += 32) { float wv[32];
#pragma unroll
            for (int j = 0; j < 32; ++j) wv[j] = a.w_mod[(size_t)(k0 + j) * 6144 + col];
#pragma unroll
            for (int j = 0; j < 32; ++j) { const float w = wv[j]; a0 += sc[k0 + j] * w; a1 += sc[1024 + k0 + j] * w; a2 += sc[2048 + k0 + j] * w; a3 += sc[3072 + k0 + j] * w; } }
        part[(wave * 4 + 0) * 64 + lane] = a0; part[(wave * 4 + 1) * 64 + lane] = a1; part[(wave * 4 + 2) * 64 + lane] = a2; part[(wave * 4 + 3) * 64 + lane] = a3;
        __syncthreads();
        if (tid < 256) { const int b = tid >> 6, cc = tid & 63; float s = 0.f;
#pragma unroll
            for (int w = 0; w < 8; ++w) s += part[(w * 4 + b) * 64 + cc];
            MOD[b * 6144 + 64 * m + cc] = s + a.b_mod[64 * m + cc]; }
        __syncthreads();
      } }
    if (vcu == 0) { float* GN = (float*)(ws + WS_GAINS);
        if (tid < 128) GN[tid] = a.g_q_dsa[tid]; else if (tid < 256) GN[tid] = a.g_k_dsa[tid - 128]; else if (tid < 384) GN[tid] = a.g_q_moba[tid - 256]; else GN[tid] = a.g_k_moba[tid - 384]; }
    { LAS float* scr = (LAS float*)(lds + 32768 + wave * 8448);
      const bool split = G >= 192; const int gw = (split ? vcu - 96 : vcu) * NWAVES + wave, NGW = (split ? G - 96 : G) * NWAVES;
      constexpr int I_IN = 16 * (NIN / 32);
      if (gw >= 0) for (int it = gw; it < I_IN; it += NGW) cvt_item(a.w_in, INW, 1024, (h16*)(ws + WS_WIN), NIN / 32, it, MapIn{}, scr, lane);
      }
    { float* C128 = (float*)(ws + WS_COS128); float* S128 = (float*)(ws + WS_SIN128); float* C64 = (float*)(ws + WS_COS64); float* S64 = (float*)(ws + WS_SIN64);
      const int gt = vcu * 512 + tid, NGT = G * 512;
      { const int i = gt & 63; const float inv = (float)pow(10000.0, -(double)(2 * i) / 128.0);
        for (int e = gt; e < S_ * 64; e += NGT) { const int t = e >> 6; float sn, cs; sincosf((float)t * inv, &sn, &cs); C128[e] = cs; S128[e] = sn; } }
      { const int i = gt & 31; const float inv = (float)pow(10000.0, -(double)(2 * i) / 64.0);
        for (int e = gt; e < S_ * 32; e += NGT) { const int t = e >> 5; float sn, cs; sincosf((float)t * inv, &sn, &cs); C64[e] = cs; S64[e] = sn; } } }
}

__device__ __forceinline__ void p1_hn(const Args& a, int vcu, int G, int lane, int wave) {
    unsigned char* ws = a.ws; const float* MOD = (const float*)(ws + WS_MOD); h16* HN = (h16*)(ws + WS_HN);
    const int gw = vcu * NWAVES + wave, NGW = G * NWAVES;
    if (T_ % NGW != 0 || S_ % (T_ / NGW) != 0) {
        for (int row = gw; row < T_; row += NGW) { const int b = row >> 12; const GAS f32x4* xr = (const GAS f32x4*)(a.x + (size_t)row * D_) + lane; f32x4 v[4]; float t = 0.f;
#pragma unroll
            for (int j = 0; j < 4; ++j) { v[j] = xr[64 * j]; t += (v[j].x * v[j].x + v[j].y * v[j].y) + (v[j].z * v[j].z + v[j].w * v[j].w); }
            const float r = rsqrtf(wave_sum(t) * (1.f / D_) + EPS); GAS u32x2* o = (GAS u32x2*)(HN + (size_t)row * D_) + lane;
#pragma unroll
            for (int j = 0; j < 4; ++j) { const int k = 4 * lane + 256 * j; o[64 * j] = pkh4(v[j] * r * *(const f32x4*)(a.g_mix + k) * (*(const f32x4*)(MOD + b * 6144 + 1024 + k) + 1.f) + *(const f32x4*)(MOD + b * 6144 + k)); } }
    } else
    { const int rpw = T_ / NGW;
      const int rbase = gw * rpw, b = rbase >> 12;
      f32x4 gs[4], shv[4];
#pragma unroll
      for (int j = 0; j < 4; ++j) { const int k = 4 * lane + 256 * j; gs[j] = *(const f32x4*)(a.g_mix + k) * (*(const f32x4*)(MOD + b * 6144 + 1024 + k) + 1.f); shv[j] = *(const f32x4*)(MOD + b * 6144 + k); }
      for (int r0 = 0; r0 < rpw; r0 += 4) {
        f32x4 v[4][4]; float ss[4];
#pragma unroll
        for (int q = 0; q < 4; ++q) { const int row = rbase + (r0 + q < rpw ? r0 + q : rpw - 1); const GAS f32x4* xr = (const GAS f32x4*)(a.x + (size_t)row * D_) + lane;
#pragma unroll
            for (int j = 0; j < 4; ++j) v[q][j] = xr[64 * j]; }
#pragma unroll
        for (int q = 0; q < 4; ++q) { float t = 0.f;
#pragma unroll
            for (int j = 0; j < 4; ++j) t += (v[q][j].x * v[q][j].x + v[q][j].y * v[q][j].y) + (v[q][j].z * v[q][j].z + v[q][j].w * v[q][j].w);
            ss[q] = t; }
#pragma unroll
        for (int o = 1; o < 64; o <<= 1) {
#pragma unroll
            for (int q = 0; q < 4; ++q) ss[q] += __shfl_xor(ss[q], o); }
#pragma unroll
        for (int q = 0; q < 4; ++q) if (r0 + q < rpw) { const float r = rsqrtf(ss[q] * (1.f / D_) + EPS); GAS u32x2* o = (GAS u32x2*)(HN + (size_t)(rbase + r0 + q) * D_) + lane;
#pragma unroll
            for (int j = 0; j < 4; ++j) o[64 * j] = pkh4(v[q][j] * r * gs[j] + shv[j]); }
      } }
}
__device__ __forceinline__ void p5_bias2(const Args& a, int vcu, int G, int lane, int wave) {
    unsigned char* ws = a.ws; const float* MOD = (const float*)(ws + WS_MOD);
    const int gw = vcu * NWAVES + wave, NGW = G * NWAVES;
    const h16* WGU = (const h16*)(ws + WS_WGU); float* BIAS2 = (float*)(ws + WS_BIAS2);
    for (int cp = gw; cp < NGU; cp += NGW) {
        const h16* wrow = WGU + (size_t)cp * 1024 + lane * 16;
        float d0 = 0.f, d1 = 0.f, d2 = 0.f, d3 = 0.f;
#pragma unroll
        for (int e = 0; e < 16; ++e) { const float w = (float)wrow[e]; const float* sh = MOD + 3072 + lane * 16 + e;
            d0 += w * sh[0]; d1 += w * sh[6144]; d2 += w * sh[2 * 6144]; d3 += w * sh[3 * 6144]; }
        d0 = wave_sum(d0); d1 = wave_sum(d1); d2 = wave_sum(d2); d3 = wave_sum(d3);
        if (lane == 0) { BIAS2[cp] = d0; BIAS2[NGU + cp] = d1; BIAS2[2 * NGU + cp] = d2; BIAS2[3 * NGU + cp] = d3; }
    }
}

__device__ __forceinline__ void rot8(const f32x4 (&c0)[2], const f32x4 (&s0)[2], const LAS float* dc, const LAS float* ds, f32x4 (&cs)[2], f32x4 (&sn)[2]) {
#pragma unroll
    for (int n = 0; n < 2; ++n) { const f32x4 cd = *(const LAS f32x4*)(dc + 4 * n), sd = *(const LAS f32x4*)(ds + 4 * n); cs[n] = c0[n] * cd - s0[n] * sd; sn[n] = s0[n] * cd + c0[n] * sd; }
}
struct EpiInProj {
    int noepi; unsigned char* ws; h16* GA;
    __device__ __forceinline__ bool operator()(pg8::Acc& acc, const pg8::Unit& u, const pg8::Unit& nxt, bool has_next, int ui, int wr, int wc, int fr, int fq, int wid, int lane, LAS unsigned char* scr) const {
        if (noepi) return true;
        const int pn = u.pn, ty = in_tile_type(pn), row0 = u.pm * 256 + wr * 64 + fr;
        if (ty == 1) {
            h16* dst; int ld, cb; bool sig = false;
            if (pn < 6) { dst = (h16*)(ws + WS_VA); ld = 512; cb = 256 * (pn - 4); } else if (pn < 14) { dst = (h16*)(ws + WS_VB); ld = 512; cb = 256 * (pn - 12); }
            else if (pn < 18) { dst = GA; ld = 1024; cb = 256 * (pn - 14); sig = true; } else { dst = GA + (size_t)T_ * 1024; ld = 1024; cb = 256 * (pn - 18); sig = true; }
#pragma unroll
            for (int ai = 0; ai < 2; ++ai)
#pragma unroll
                for (int m = 0; m < 4; ++m) { h16* rp = dst + (size_t)(row0 + ai * 128 + m * 16) * ld + cb + 32 * wc + 8 * fq;
#pragma unroll
                    for (int bj = 0; bj < 2; ++bj) { f32x4 v0 = acc[ai][bj][m][0], v1 = acc[ai][bj][m][1];
                        if (sig) {
#pragma unroll
                            for (int j = 0; j < 4; ++j) { v0[j] = fmaxf(sigmoidf_(v0[j]), 6.2e-5f); v1[j] = fmaxf(sigmoidf_(v1[j]), 6.2e-5f); } }
                        *(u32x4*)(rp + 128 * bj) = pkh8(v0, v1); } }
            return true;
        }
        const int t0 = row0 & (S_ - 1);
        if (ty == 0) {
            LAS float* P = (LAS float*)(scr + SCR_P);
            const int hl = wc >> 1, d0 = 32 * (wc & 1) + 8 * fq;
            const float* gain = (const float*)(ws + WS_GAINS) + 128 * (pn < 2 ? 0 : pn < 4 ? 1 : pn < 10 ? 2 : 3);
            f32x4 g1[2], g2[2], c0[2], s0[2];
#pragma unroll
            for (int n = 0; n < 2; ++n) { g1[n] = *(const f32x4*)(gain + d0 + 4 * n); g2[n] = *(const f32x4*)(gain + 64 + d0 + 4 * n);
                c0[n] = *(const f32x4*)((const float*)(ws + WS_COS128) + t0 * 64 + d0 + 4 * n); s0[n] = *(const f32x4*)((const float*)(ws + WS_SIN128) + t0 * 64 + d0 + 4 * n); }
#pragma unroll
            for (int ai = 0; ai < 2; ++ai)
#pragma unroll
                for (int m = 0; m < 4; ++m) { float s = 0.f;
#pragma unroll
                    for (int bj = 0; bj < 2; ++bj)
#pragma unroll
                        for (int n = 0; n < 2; ++n) { const f32x4 x = acc[ai][bj][m][n]; s += (x[0] * x[0] + x[1] * x[1]) + (x[2] * x[2] + x[3] * x[3]); }
                    s += __shfl_xor(s, 16); s += __shfl_xor(s, 32);
                    if (fq == 0) P[((ai * 128 + wr * 64 + m * 16 + fr) * 2 + hl) * 2 + (wc & 1)] = s; }
            EPI_LWAIT_BAR();
            h16* dst = (h16*)(ws + (pn < 2 ? WS_QA : pn < 4 ? WS_KA : pn < 10 ? WS_QB : WS_KB));
            h16* dlo = (h16*)(ws + WS_QBL); const bool has_lo = (pn == 8 || pn == 9), has_km = (pn >= 10);
            const int hb = 256 * (pn & 1) + 128 * hl + d0;
            const LAS float* DTc = (const LAS float*)(scr + SCR_DT128), * DTs = DTc + 512;
            f32x4 ks1[2] = {{0.f, 0.f, 0.f, 0.f}, {0.f, 0.f, 0.f, 0.f}}, ks2[2] = {{0.f, 0.f, 0.f, 0.f}, {0.f, 0.f, 0.f, 0.f}};
#pragma unroll
            for (int ai = 0; ai < 2; ++ai)
#pragma unroll
                for (int m = 0; m < 4; ++m) { const int rowl = ai * 128 + wr * 64 + m * 16 + fr, row = u.pm * 256 + rowl, ci = ai * 4 + m;
                    f32x4 cs[2], sn[2]; rot8(c0, s0, DTc + ci * 64 + d0, DTs + ci * 64 + d0, cs, sn);
                    const f32x2 p2 = *(const LAS f32x2*)(P + (rowl * 2 + hl) * 2);
                    const float r = rsqrtf((p2[0] + p2[1]) * (1.f / 128.f) + EPS);
                    f32x4 o1[2], o2[2];
#pragma unroll
                    for (int n = 0; n < 2; ++n) { const f32x4 x1 = acc[ai][0][m][n] * r * g1[n], x2 = acc[ai][1][m][n] * r * g2[n]; o1[n] = x1 * cs[n] - x2 * sn[n]; o2[n] = x2 * cs[n] + x1 * sn[n]; }
                    const u32x4 h1 = pkh8(o1[0], o1[1]), h2 = pkh8(o2[0], o2[1]);
                    h16* rp = dst + (size_t)row * 512 + hb; *(u32x4*)rp = h1; *(u32x4*)(rp + 64) = h2;
                    if (has_lo) { f32x4 a0, a1, b0, b1; unpk8(h1, a0, a1); unpk8(h2, b0, b1); h16* lp = dlo + (size_t)row * 512 + hb;
                        *(u32x4*)lp = pkh8(o1[0] - a0, o1[1] - a1); *(u32x4*)(lp + 64) = pkh8(o2[0] - b0, o2[1] - b1); }
                    if (has_km) { ks1[0] += o1[0]; ks1[1] += o1[1]; ks2[0] += o2[0]; ks2[1] += o2[1]; } }
            if (has_km) {
                LAS float* KS = (LAS float*)(scr + SCR_KS);
#pragma unroll
                for (int n = 0; n < 2; ++n)
#pragma unroll
                    for (int j = 0; j < 4; ++j) { float v1 = ks1[n][j], v2 = ks2[n][j];
#pragma unroll
                        for (int o = 1; o < 16; o <<= 1) { v1 += __shfl_xor(v1, o); v2 += __shfl_xor(v2, o); }
                        if (fr == 0) { KS[(wr * 2 + hl) * 128 + d0 + 4 * n + j] = v1; KS[(wr * 2 + hl) * 128 + 64 + d0 + 4 * n + j] = v2; } }
                EPI_LWAIT_BAR();
                const int tid = wid * 64 + lane;
                if (tid < 256) { const int h2 = tid >> 7, dd = tid & 127; const float v = (KS[(0 * 2 + h2) * 128 + dd] + KS[(1 * 2 + h2) * 128 + dd]) * (1.f / 256.f);
                    const int b = u.pm >> 4, blk = u.pm & 15, h = 2 * (pn & 1) + h2;
                    ((float*)(ws + WS_KMEAN))[((size_t)(b * NH + h) * NBLK + blk) * HD + dd] = v; }
            }
            return true;
        }
        const LAS float* DTc = (const LAS float*)(scr + SCR_DT64), * DTs = DTc + 256;
        const int e0 = 8 * fq;
        if (ty == 2 || wc == 0) {
            f32x4 c0[2], s0[2];
#pragma unroll
            for (int n = 0; n < 2; ++n) { c0[n] = *(const f32x4*)((const float*)(ws + WS_COS64) + t0 * 32 + e0 + 4 * n); s0[n] = *(const f32x4*)((const float*)(ws + WS_SIN64) + t0 * 32 + e0 + 4 * n); }
            h16* dst = ty == 2 ? (h16*)(ws + WS_QI) + 64 * (4 * (pn - 6) + wc) + e0 : (h16*)(ws + WS_KI) + e0; const int ld = ty == 2 ? 512 : 64;
#pragma unroll
            for (int ai = 0; ai < 2; ++ai)
#pragma unroll
                for (int m = 0; m < 4; ++m) { const int row = row0 + ai * 128 + m * 16, ci = ai * 4 + m;
                    f32x4 cs[2], sn[2]; rot8(c0, s0, DTc + ci * 32 + e0, DTs + ci * 32 + e0, cs, sn);
                    f32x4 o1[2], o2[2];
#pragma unroll
                    for (int n = 0; n < 2; ++n) { const f32x4 x1 = acc[ai][0][m][n], x2 = acc[ai][1][m][n]; o1[n] = x1 * cs[n] - x2 * sn[n]; o2[n] = x2 * cs[n] + x1 * sn[n]; }
                    h16* rp = dst + (size_t)row * ld; *(u32x4*)rp = pkh8(o1[0], o1[1]); *(u32x4*)(rp + 32) = pkh8(o2[0], o2[1]); }
        } else if (wc == 1 && fq == 0) { float* dst = (float*)(ws + WS_WI); const float scale = 0.35355339059327373f * 0.125f;
#pragma unroll
            for (int ai = 0; ai < 2; ++ai)
#pragma unroll
                for (int m = 0; m < 4; ++m) { const int row = row0 + ai * 128 + m * 16; *(f32x4*)(dst + (size_t)row * 8) = acc[ai][0][m][0] * scale; *(f32x4*)(dst + (size_t)row * 8 + 4) = acc[ai][0][m][1] * scale; } }
        return true;
    }
};
__device__ __forceinline__ void fill_rope_deltas(const unsigned char* ws, LAS unsigned char* scr, int tid) {
    LAS float* D128 = (LAS float*)(scr + SCR_DT128); LAS float* D64 = (LAS float*)(scr + SCR_DT64);
    { const int ci = tid >> 6, i = tid & 63, dl = 128 * (ci >> 2) + 16 * (ci & 3); D128[tid] = ((const float*)(ws + WS_COS128))[dl * 64 + i]; D128[512 + tid] = ((const float*)(ws + WS_SIN128))[dl * 64 + i]; }
    if (tid < 256) { const int ci = tid >> 5, i = tid & 31, dl = 128 * (ci >> 2) + 16 * (ci & 3); D64[tid] = ((const float*)(ws + WS_COS64))[dl * 32 + i]; D64[256 + tid] = ((const float*)(ws + WS_SIN64))[dl * 32 + i]; }
    __syncthreads();
}

struct EpiBranch {
    __device__ __forceinline__ bool idem(const pg8::Unit& u) const { return u.seg != 0; }
    const h16* GA; const h16* GB; h16* MERGED;
    __device__ __forceinline__ bool operator()(pg8::Acc& acc, const pg8::Unit& u, const pg8::Unit& nxt, bool has_next, int ui, int wr, int wc, int fr, int fq, int wid, int lane, LAS unsigned char* scr) const {
        const int row0 = u.pm * 256 + wr * 64 + fr, cb = u.pn * 256 + 32 * wc + 8 * fq;
#pragma unroll
        for (int ai = 0; ai < 2; ++ai) {
            u32x4 gbv[4][2], gav[4][2];
#pragma unroll
            for (int m = 0; m < 4; ++m)
#pragma unroll
                for (int bj = 0; bj < 2; ++bj) { const size_t ro = (size_t)(row0 + ai * 128 + m * 16) * 1024 + cb + 128 * bj; gbv[m][bj] = *(const u32x4*)(GB + ro); if (u.seg == 0) gav[m][bj] = *(const u32x4*)(GA + ro); }
#pragma unroll
            for (int m = 0; m < 4; ++m)
#pragma unroll
                for (int bj = 0; bj < 2; ++bj) { const size_t ro = (size_t)(row0 + ai * 128 + m * 16) * 1024 + cb + 128 * bj;
                    f32x4 b0, b1; unpk8(gbv[m][bj], b0, b1);
                    if (u.seg == 0) { f32x4 a0, a1; unpk8(gav[m][bj], a0, a1);
#pragma unroll
                        for (int j = 0; j < 4; ++j) { acc[ai][bj][m][0][j] *= a0[j] * __builtin_amdgcn_rcpf(b0[j]); acc[ai][bj][m][1][j] *= a1[j] * __builtin_amdgcn_rcpf(b1[j]); } }
                    else *(u32x4*)(MERGED + ro) = pkh8(acc[ai][bj][m][0] * b0, acc[ai][bj][m][1] * b1); }
        }
        return u.seg != 0;
    }
};

__device__ __forceinline__ h16* x1h_base(unsigned char* ws, int pm) { return pm < X1H_SPLIT ? (h16*)(ws + WS_X1HA) : (h16*)(ws + WS_X1HB) - (size_t)X1H_SPLIT * 256 * 1024; }
struct EpiOut {
    __device__ __forceinline__ bool idem(const pg8::Unit&) const { return true; }
    const float* x; const float* g_ffn; const float* MOD; unsigned char* ws; h16* A2; float* SSQ;
    __device__ __forceinline__ bool operator()(pg8::Acc& acc, const pg8::Unit& u, const pg8::Unit& nxt, bool has_next, int ui, int wr, int wc, int fr, int fq, int wid, int lane, LAS unsigned char* scr) const {
        const int row0 = u.pm * 256 + wr * 64 + fr, cb = u.pn * 256 + 32 * wc + 8 * fq, b = u.pm >> 4;
        h16* X1H = x1h_base(ws, u.pm);
        f32x4 gt[2][2], g2[2][2];
#pragma unroll
        for (int bj = 0; bj < 2; ++bj)
#pragma unroll
            for (int n = 0; n < 2; ++n) { const int c = cb + 128 * bj + 4 * n; gt[bj][n] = *(const f32x4*)(MOD + b * 6144 + 2048 + c);
                g2[bj][n] = *(const f32x4*)(g_ffn + c) * (*(const f32x4*)(MOD + b * 6144 + 4096 + c) + 1.f); }
#pragma unroll
        for (int ai = 0; ai < 2; ++ai)
#pragma unroll
          for (int mp = 0; mp < 2; ++mp) {
            f32x4 xv[2][2][2];
#pragma unroll
            for (int mm = 0; mm < 2; ++mm)
#pragma unroll
                for (int bj = 0; bj < 2; ++bj) { const float* xp = x + (size_t)(row0 + ai * 128 + (2 * mp + mm) * 16) * 1024 + cb + 128 * bj; xv[mm][bj][0] = *(const f32x4*)xp; xv[mm][bj][1] = *(const f32x4*)(xp + 4); }
#pragma unroll
            for (int mm = 0; mm < 2; ++mm) { const int m = 2 * mp + mm; const int row = row0 + ai * 128 + m * 16; const size_t ro = (size_t)row * 1024 + cb; float s = 0.f;
#pragma unroll
                for (int bj = 0; bj < 2; ++bj) {
                    const f32x4 y0 = xv[mm][bj][0] + gt[bj][0] * acc[ai][bj][m][0], y1 = xv[mm][bj][1] + gt[bj][1] * acc[ai][bj][m][1];
                    *(u32x4*)(X1H + ro + 128 * bj) = pkh8(y0, y1);
                    *(u32x4*)(A2 + ro + 128 * bj) = pkh8(y0 * g2[bj][0], y1 * g2[bj][1]);
                    s += (y0[0] * y0[0] + y0[1] * y0[1]) + (y0[2] * y0[2] + y0[3] * y0[3]) + (y1[0] * y1[0] + y1[1] * y1[1]) + (y1[2] * y1[2] + y1[3] * y1[3]); }
                s += __shfl_xor(s, 16); s += __shfl_xor(s, 32);
                if (fq == 0) SSQ[(size_t)row * 16 + 4 * u.pn + wc] = s; }
          }
        return true;
    }
};

template <int NAI>
struct EpiGUT {
    int noepi;
    __device__ __forceinline__ bool idem(const pg8::Unit&) const { return true; }
    const float* SSQ; const float* BIAS2; h16* ACT;
    __device__ __forceinline__ bool operator()(pg8::Acc& acc, const pg8::Unit& u, const pg8::Unit& nxt, bool has_next, int ui, int wr, int wc, int fr, int fq, int wid, int lane, LAS unsigned char* scr) const {
        if (noepi) return true;
        const int tid = wid * 64 + lane, b = u.pm >> 4;
        LAS float* R = (LAS float*)(scr + SCR_R) + (ui & 1) * 256; LAS float* Rn = (LAS float*)(scr + SCR_R) + ((ui + 1) & 1) * 256;
        f32x4 bs[2][2];
#pragma unroll
        for (int bj = 0; bj < 2; ++bj)
#pragma unroll
            for (int n = 0; n < 2; ++n) bs[bj][n] = *(const f32x4*)(BIAS2 + b * NGU + u.pn * 256 + 128 * bj + 32 * wc + 16 * n + 4 * fq);
        if (ui == 0) {
            if (tid < 256) { const float* sp = SSQ + (size_t)(u.pm * 256 + tid) * 16; const f32x4 s0 = *(const f32x4*)sp, s1 = *(const f32x4*)(sp + 4), s2 = *(const f32x4*)(sp + 8), s3 = *(const f32x4*)(sp + 12);
                const f32x4 s = (s0 + s1) + (s2 + s3); R[tid] = rsqrtf(((s[0] + s[1]) + (s[2] + s[3])) * (1.f / 1024.f) + EPS); }
            EPI_LWAIT_BAR();
        }
        f32x4 n0, n1, n2, n3; const bool donext = has_next && tid < 256;
        if (donext) { const float* sp = SSQ + (size_t)(nxt.pm * 256 + tid) * 16; n0 = *(const f32x4*)sp; n1 = *(const f32x4*)(sp + 4); n2 = *(const f32x4*)(sp + 8); n3 = *(const f32x4*)(sp + 12); }
#pragma unroll
        for (int ai = 0; ai < NAI; ++ai)
#pragma unroll
            for (int m = 0; m < 4; ++m) { const int rowl = (NAI == 1 ? u.seg : ai) * 128 + wr * 64 + m * 16 + fr; const float r = R[rowl]; h16* rp = ACT + (size_t)(u.pm * 256 + rowl) * DFF + 128 * u.pn + 16 * wc + 4 * fq;
#pragma unroll
                for (int bj = 0; bj < 2; ++bj) { const f32x4 g = acc[ai][bj][m][0] * r + bs[bj][0], uu = acc[ai][bj][m][1] * r + bs[bj][1]; f32x4 o;
#pragma unroll
                    for (int j = 0; j < 4; ++j) o[j] = g[j] * sigmoidf_(g[j]) * uu[j];
                    *(u32x2*)(rp + 64 * bj) = pkh4(o); } }
        if (donext) { const f32x4 s = (n0 + n1) + (n2 + n3); Rn[tid] = rsqrtf(((s[0] + s[1]) + (s[2] + s[3])) * (1.f / 1024.f) + EPS); }
        return true;
    }
};

struct EpiDown {
    __device__ __forceinline__ bool idem(const pg8::Unit&) const { return true; }
    const float* MOD; unsigned char* ws; float* out;
    __device__ __forceinline__ bool operator()(pg8::Acc& acc, const pg8::Unit& u, const pg8::Unit& nxt, bool has_next, int ui, int wr, int wc, int fr, int fq, int wid, int lane, LAS unsigned char* scr) const {
        const int row0 = u.pm * 256 + wr * 64 + fr, cb = u.pn * 256 + 32 * wc + 8 * fq, b = u.pm >> 4;
        const h16* X1H = x1h_base(ws, u.pm);
        f32x4 gt[2][2];
#pragma unroll
        for (int bj = 0; bj < 2; ++bj)
#pragma unroll
            for (int n = 0; n < 2; ++n) gt[bj][n] = *(const f32x4*)(MOD + b * 6144 + 5120 + cb + 128 * bj + 4 * n);
#pragma unroll
        for (int ai = 0; ai < 2; ++ai) {
            u32x4 xh[4][2];
#pragma unroll
            for (int m = 0; m < 4; ++m)
#pragma unroll
                for (int bj = 0; bj < 2; ++bj) xh[m][bj] = *(const u32x4*)(X1H + (size_t)(row0 + ai * 128 + m * 16) * 1024 + cb + 128 * bj);
#pragma unroll
            for (int m = 0; m < 4; ++m) { const size_t ro = (size_t)(row0 + ai * 128 + m * 16) * 1024 + cb;
#pragma unroll
                for (int bj = 0; bj < 2; ++bj) { float* p = out + ro + 128 * bj; f32x4 xa, xb; unpk8(xh[m][bj], xa, xb);
                    *(f32x4*)p = xa + gt[bj][0] * acc[ai][bj][m][0]; *(f32x4*)(p + 4) = xb + gt[bj][1] * acc[ai][bj][m][1]; } }
        }
        return true;
    }
};


#ifndef REP_MM
#define REP_MM 1
#endif
#ifndef REP_SEL
#define REP_SEL 1
#endif
#ifndef REP_MOBA
#define REP_MOBA 1
#endif
namespace idxp {
typedef float f32x16 __attribute__((ext_vector_type(16)));
typedef float f32x2 __attribute__((ext_vector_type(2)));
typedef short s16x2 __attribute__((ext_vector_type(2)));
constexpr int LDS_S = 0, LDS_H = 131072, LDS_WT = LDS_H + 16384, LDS_KM = 0;
static_assert(LDS_WT + 512 <= MISC_OFF, "indexer LDS map");
__device__ __forceinline__ unsigned fkey16(float sc) {
    const short hb = __builtin_bit_cast(short, (h16)sc);
    return (unsigned)(unsigned short)(hb ^ (short)((hb >> 15) | (short)0x8000));
}
__device__ __forceinline__ unsigned suffix_sum(unsigned v, int lane) {
#pragma unroll
    for (int o = 1; o < 64; o <<= 1) { const unsigned u = __shfl_down(v, o); v += (lane + o < 64) ? u : 0u; }
    return v;
}
__device__ __forceinline__ unsigned prefix_sum_incl(unsigned v, int lane) {
#pragma unroll
    for (int o = 1; o < 64; o <<= 1) { const unsigned u = __shfl_up(v, o); v += (lane >= o) ? u : 0u; }
    return v;
}
__device__ __forceinline__ void find_bin(const LAS unsigned* H, unsigned K, int lane, unsigned& bin, unsigned& above, unsigned& inbin) {
    const u32x4 h = *(const LAS u32x4*)(H + 4 * lane);
    const unsigned s = (h[0] + h[1]) + (h[2] + h[3]);
    const unsigned S = suffix_sum(s, lane), ab = S - s;
    const bool mine = ab < K && K <= S;
    unsigned c = ab, bsel = 0, asel = 0, isel = 0; bool done = false;
#pragma unroll
    for (int j = 3; j >= 0; --j) { if (!done && c + h[j] >= K) { bsel = 4 * lane + j; asel = c; isel = h[j]; done = true; } c += h[j]; }
    const unsigned long long bm = __ballot(mine);
    const int ls = __builtin_amdgcn_readfirstlane(bm ? __ffsll((long long)bm) - 1 : 0);
    bin = __builtin_amdgcn_readlane(bsel, ls); above = __builtin_amdgcn_readlane(asel, ls); inbin = __builtin_amdgcn_readlane(isel, ls);
}
__device__ __forceinline__ void find_bin9(const LAS unsigned* H, unsigned K, int lane, unsigned& bin, unsigned& above) {
    const u32x4 h = *(const LAS u32x4*)(H + 4 * lane);
    unsigned cnt[8];
#pragma unroll
    for (int j = 0; j < 8; ++j) cnt[j] = (h[j >> 1] >> (16 * (j & 1))) & 0xffffu;
    const unsigned s = ((cnt[0] + cnt[1]) + (cnt[2] + cnt[3])) + ((cnt[4] + cnt[5]) + (cnt[6] + cnt[7]));
    const unsigned S = suffix_sum(s, lane), ab = S - s;
    const bool mine = ab < K && K <= S;
    unsigned c = ab, bsel = 0, asel = 0; bool done = false;
#pragma unroll
    for (int j = 7; j >= 0; --j) { if (!done && c + cnt[j] >= K) { bsel = 8 * lane + j; asel = c; done = true; } c += cnt[j]; }
    const unsigned long long bm = __ballot(mine);
    const int ls = __builtin_amdgcn_readfirstlane(bm ? __ffsll((long long)bm) - 1 : 0);
    bin = __builtin_amdgcn_readlane(bsel, ls); above = __builtin_amdgcn_readlane(asel, ls);
}
constexpr int CV_A = 8 * 32, CV_OUT = 16 * 32, CV_GU = 16 * (NGU / 32), CV_DN = (DFF / 64) * 32, CV_BLOCKS = 2 * CV_A + CV_OUT + CV_GU + CV_DN, CV_STEPS = CV_BLOCKS / NWAVES;
static_assert(CV_BLOCKS % NWAVES == 0 && CV_STEPS <= 768, "late conversion steps fit the first three indexer items of every workgroup");
struct CvtLate { const float* src; h16* dst; int ldw, K; };
__device__ __forceinline__ CvtLate cvt_late_addr(const Args& a, int blk, int lane) {
    const float* W; h16* WT; int ldw, K, ngrp, r = blk; bool gu = false; unsigned char* ws = a.ws;
    if (r < CV_A) { W = a.w_br_dsa; WT = (h16*)(ws + WS_WA); ldw = 1024; K = 512; ngrp = 32; }
    else if (r < 2 * CV_A) { r -= CV_A; W = a.w_br_moba; WT = (h16*)(ws + WS_WB); ldw = 1024; K = 512; ngrp = 32; }
    else if (r < 2 * CV_A + CV_OUT) { r -= 2 * CV_A; W = a.w_out; WT = (h16*)(ws + WS_WOUT); ldw = 1024; K = 1024; ngrp = 32; }
    else if (r < 2 * CV_A + CV_OUT + CV_GU) { r -= 2 * CV_A + CV_OUT; W = a.w_gate_up; WT = (h16*)(ws + WS_WGU); ldw = NGU; K = 1024; ngrp = NGU / 32; gu = true; }
    else { r -= 2 * CV_A + CV_OUT + CV_GU; W = a.w_down; WT = (h16*)(ws + WS_WDN); ldw = 1024; K = DFF; ngrp = 32; }
    const int kb = r / ngrp, grp = r - kb * ngrp, ko = lane & 7, cp = 32 * grp + 4 * (lane >> 3);
    const int sc = gu ? MapGU{}(cp) : MapPlain{}(cp);
    CvtLate c; c.src = W + (size_t)(64 * kb + 8 * ko) * ldw + sc; c.dst = WT + (size_t)cp * K + 64 * kb + 8 * ko; c.ldw = ldw; c.K = K; return c;
}
__device__ __forceinline__ void idx_item(const Args& a, int cstep, const h16* QI, const h16* KI, const float* WI, u64* MASK, LAS unsigned char* lds, int b, int i, int tid, int lane, int wave) {
    asm volatile("" : "+v"(lane));
    LAS unsigned short* S = (LAS unsigned short*)(lds + LDS_S);
    const int t0 = 16 * i, c = lane & 31, hh = lane >> 5;
    const int n32 = (t0 + 15) / 32 + 1;
    const int nwords = 4 * (t0 >> 8) + 4;
    const int nit = (nwords + 7) / 8;
    const int n32z = nit * 16;
    f16x8 A[4][4]; f32x4 wl[4][4];
    LAS unsigned* HA = (LAS unsigned*)(lds + LDS_H);
    *(LAS u32x4*)(HA + 8 * tid) = (u32x4){0u, 0u, 0u, 0u}; *(LAS u32x4*)(HA + 8 * tid + 4) = (u32x4){0u, 0u, 0u, 0u};
    LAS float* WT = (LAS float*)(lds + LDS_WT);
    if (tid < 128) { const float wv = WI[(size_t)(b * S_ + t0) * 8 + tid]; WT[tid] = wv > 0.f ? __builtin_inff() : -__builtin_inff(); }
    { const int rho = lane & 31, qq = 2 * ((rho >> 2) & 1) + (rho >> 4), head = (rho & 3) + 4 * ((rho >> 3) & 1);
#pragma unroll
      for (int rt = 0; rt < 4; ++rt) { const h16* qp = QI + (size_t)(b * S_ + t0 + 4 * rt + qq) * 512 + head * 64 + 8 * hh;
#pragma unroll
          for (int ks = 0; ks < 4; ++ks) A[rt][ks] = *(const f16x8*)(qp + 16 * ks);
          { const float* wp_ = WI + (size_t)(b * S_ + t0 + 4 * rt + 2 * hh) * 8;
#pragma unroll
            for (int e4 = 0; e4 < 4; ++e4) { const f32x4 wq = *(const f32x4*)(wp_ + 4 * e4);
#pragma unroll
                for (int j = 0; j < 4; ++j) wl[rt][e4][j] = wq[j] > 0.f ? __builtin_inff() : -__builtin_inff(); } }
          const float wv = WI[(size_t)(b * S_ + t0 + 4 * rt + qq) * 8 + head];
#pragma unroll
          for (int ks = 0; ks < 4; ++ks)
#pragma unroll
              for (int e = 0; e < 8; ++e) A[rt][ks][e] = (h16)((float)A[rt][ks][e] * wv); } }
    __syncthreads();
    f16x8 bf[4];
    if (wave < n32) { const h16* kp = KI + (size_t)(b * S_ + 32 * wave + c) * 64 + 8 * hh;
#pragma unroll
        for (int ks = 0; ks < 4; ++ks) bf[ks] = *(const f16x8*)(kp + 16 * ks); }
    for (int kt = wave; kt < n32; kt += NWAVES) {
        f16x8 bn[4];
        { const int ktn = kt + NWAVES < n32 ? kt + NWAVES : kt; const h16* kp = KI + (size_t)(b * S_ + 32 * ktn + c) * 64 + 8 * hh;
#pragma unroll
          for (int ks = 0; ks < 4; ++ks) bn[ks] = *(const f16x8*)(kp + 16 * ks); }
        const int s = 32 * kt + c;
        f32x16 acc[4];
#pragma unroll
        for (int rt = 0; rt < 4; ++rt) acc[rt] = f32x16{};
#pragma unroll
        for (int ks = 0; ks < 4; ++ks)
#pragma unroll
            for (int rt = 0; rt < 4; ++rt) acc[rt] = __builtin_amdgcn_mfma_f32_32x32x16_f16(A[rt][ks], bf[ks], acc[rt], 0, 0, 0);
        const bool diag = 32 * kt + 31 > t0;
#pragma unroll
        for (int rt = 0; rt < 4; ++rt) {
            const int q0 = 4 * rt + 2 * hh;
            const f32x4 w0 = wl[rt][0], w1 = wl[rt][1], w2 = wl[rt][2], w3 = wl[rt][3];
            float s0, s1;
#define MD(r_, w_) __builtin_amdgcn_fmed3f(acc[rt][r_], 0.f, w_)
            { const f32x2 u0 = {MD(0, w0[0]), MD(1, w0[1])}, u1 = {MD(2, w0[2]), MD(3, w0[3])}, u2 = {MD(4, w1[0]), MD(5, w1[1])}, u3 = {MD(6, w1[2]), MD(7, w1[3])};
              const f32x2 t = (u0 + u1) + (u2 + u3); s0 = t[0] + t[1]; }
            { const f32x2 u0 = {MD(8, w2[0]), MD(9, w2[1])}, u1 = {MD(10, w2[2]), MD(11, w2[3])}, u2 = {MD(12, w3[0]), MD(13, w3[1])}, u3 = {MD(14, w3[2]), MD(15, w3[3])};
              const f32x2 t = (u0 + u1) + (u2 + u3); s1 = t[0] + t[1]; }
#undef MD
            unsigned keys = pkh(s0, s1);
            { const s16x2 sg = __builtin_bit_cast(s16x2, keys) >> (s16x2){15, 15}; keys ^= __builtin_bit_cast(unsigned, sg) | 0x80008000u; }
            LAS unsigned* h0 = HA + q0 * 256;
            if (diag) { if (!(s <= t0 + q0)) keys &= 0xffff0000u; if (!(s <= t0 + q0 + 1)) keys &= 0x0000ffffu;
                if (keys & 0xffffu) (void)__hip_atomic_fetch_add(h0 + ((keys >> 8) & 0xffu), ((keys >> 7) & 1u) * 0xffffu + 1u, __ATOMIC_RELAXED, __HIP_MEMORY_SCOPE_WORKGROUP);
                if (keys >> 16) (void)__hip_atomic_fetch_add(h0 + 256 + (keys >> 24), ((keys >> 23) & 1u) * 0xffffu + 1u, __ATOMIC_RELAXED, __HIP_MEMORY_SCOPE_WORKGROUP); }
            else { (void)__hip_atomic_fetch_add(h0 + ((keys >> 8) & 0xffu), ((keys >> 7) & 1u) * 0xffffu + 1u, __ATOMIC_RELAXED, __HIP_MEMORY_SCOPE_WORKGROUP);
                   (void)__hip_atomic_fetch_add(h0 + 256 + (keys >> 24), ((keys >> 23) & 1u) * 0xffffu + 1u, __ATOMIC_RELAXED, __HIP_MEMORY_SCOPE_WORKGROUP); }
            const unsigned k0 = keys & 0xffffu, k1 = keys >> 16;
            S[q0 * 4096 + s] = (unsigned short)k0; S[(q0 + 1) * 4096 + s] = (unsigned short)k1;
        }
#pragma unroll
        for (int ks = 0; ks < 4; ++ks) bf[ks] = bn[ks];
    }
    for (int kt = n32 + wave; kt < n32z; kt += NWAVES) {
#pragma unroll
        for (int q = 0; q < 16; q += 2) S[(q + hh) * 4096 + 32 * kt + c] = (unsigned short)0;
    }
    __syncthreads();
    f32x4 wv[8]; CvtLate cv;
    if (cstep >= 0) { cv = cvt_late_addr(a, __builtin_amdgcn_readfirstlane(cstep * NWAVES + wave), lane);
#pragma unroll
        for (int k = 0; k < 8; ++k) wv[k] = *(const f32x4*)(cv.src + (size_t)k * cv.ldw); }
    u64* Mb = MASK + (size_t)b * 64 * S_;
    for (int rr = 0; rr < 2; ++rr) {
        const int q = 2 * wave + rr, t = t0 + q, N = t + 1;
        const LAS unsigned short* Srow = S + q * 4096; LAS unsigned* H = HA + q * 256;
        if (N <= TOPK) {
            if (lane < nwords) { const int n = t - 64 * lane + 1; const u64 m = n >= 64 ? ~0ull : n <= 0 ? 0ull : ((1ull << n) - 1ull); Mb[(size_t)lane * S_ + t] = m; }
            continue;
        }
        u32x4 kv[8];
#pragma unroll
        for (int it = 0; it < 8; ++it) kv[it] = it < nit ? *(const LAS u32x4*)(Srow + (it * 64 + lane) * 8) : (u32x4){0u, 0u, 0u, 0u};
        unsigned binA, cntA; find_bin9(H, (unsigned)TOPK, lane, binA, cntA);
        LDS_WAIT(); *(LAS u32x4*)(H + 4 * lane) = (u32x4){0u, 0u, 0u, 0u}; LDS_WAIT();
#pragma unroll
        for (int it = 0; it < 8; ++it) if (it < nit) {
#pragma unroll
            for (int e = 0; e < 8; ++e) { const unsigned k = (kv[it][e >> 1] >> (16 * (e & 1))) & 0xffffu; if ((k >> 7) == binA) (void)__hip_atomic_fetch_add(H + (k & 127u), 1u, __ATOMIC_RELAXED, __HIP_MEMORY_SCOPE_WORKGROUP); } }
        LDS_WAIT();
        unsigned binB, cntB, ties; find_bin(H, (unsigned)TOPK - cntA, lane, binB, cntB, ties);
        const unsigned Tk = (binA << 7) | binB, need = (unsigned)TOPK - (cntA + cntB);
        LDS_WAIT();
        unsigned taken = 0;
#pragma unroll
        for (int it = 0; it < 8; ++it) if (it < nit) {
            unsigned selb = 0;
            if (ties == need) {
#pragma unroll
                for (int e = 0; e < 8; ++e) { const unsigned k = (kv[it][e >> 1] >> (16 * (e & 1))) & 0xffffu; selb |= (k >= Tk ? 1u : 0u) << e; }
            } else {
                unsigned eq = 0;
#pragma unroll
                for (int e = 0; e < 8; ++e) { const unsigned k = (kv[it][e >> 1] >> (16 * (e & 1))) & 0xffffu; selb |= (k > Tk ? 1u : 0u) << e; eq |= (k == Tk ? 1u : 0u) << e; }
                if (__any(eq != 0u)) {
                    const unsigned cl = __popc(eq), incl = prefix_sum_incl(cl, lane); unsigned rank = taken + incl - cl;
#pragma unroll
                    for (int e = 0; e < 8; ++e) if ((eq >> e) & 1u) { if (rank < need) selb |= 1u << e; ++rank; }
                    taken += __builtin_amdgcn_readlane(incl, 63);
                }
            }
            u64 v = (u64)selb << (8 * (lane & 7));
            v |= __shfl_xor(v, 1); v |= __shfl_xor(v, 2); v |= __shfl_xor(v, 4);
            const int word = it * 8 + (lane >> 3);
            if ((lane & 7) == 0 && word < nwords) Mb[(size_t)word * S_ + t] = v;
        }
    }
    if (cstep >= 0) {
#pragma unroll
        for (int j = 0; j < 4; ++j) { u32x4 o; o.x = pkh(wv[0][j], wv[1][j]); o.y = pkh(wv[2][j], wv[3][j]); o.z = pkh(wv[4][j], wv[5][j]); o.w = pkh(wv[6][j], wv[7][j]);
            *(u32x4*)(cv.dst + (size_t)j * cv.K) = o; } }
    __syncthreads();
}
__device__ __forceinline__ void moba_select(const h16* QB, const h16* QBL, const float* KMEAN, unsigned* M16, u64* MKB, LAS unsigned char* lds, int bh, int blk, int tid) {
    LAS h16* KMh = (LAS h16*)(lds + LDS_KM); LAS h16* KMl = KMh + NBLK * HD; LAS float* Gt = (LAS float*)(lds + LDS_KM + 8192);
    for (int e = tid; e < NBLK * HD; e += NWAVES * 64) { const float km = KMEAN[(size_t)bh * NBLK * HD + e]; const h16 hv = (h16)km; KMh[e] = hv; KMl[e] = (h16)(km - (float)hv); }
    __syncthreads();
    const int b = bh >> 2, h = bh & 3, lane = tid & 63, wave = tid >> 6, c = lane & 31, hh = lane >> 5;
    if (blk > 0) {
        const size_t qo = (size_t)(b * S_ + 256 * blk + 32 * wave + c) * HW + h * HD + 8 * hh;
        f32x16 acc = {};
#pragma unroll
        for (int ks = 0; ks < 8; ++ks) { const f16x8 qh = *(const f16x8*)(QB + qo + 16 * ks), ql = *(const f16x8*)(QBL + qo + 16 * ks);
            const f16x8 kh = *(const LAS f16x8*)(KMh + (c & 15) * HD + 16 * ks + 8 * hh), kl = *(const LAS f16x8*)(KMl + (c & 15) * HD + 16 * ks + 8 * hh);
            acc = __builtin_amdgcn_mfma_f32_32x32x16_f16(ql, kh, acc, 0, 0, 0); acc = __builtin_amdgcn_mfma_f32_32x32x16_f16(qh, kl, acc, 0, 0, 0); acc = __builtin_amdgcn_mfma_f32_32x32x16_f16(qh, kh, acc, 0, 0, 0); }
        if (c < 16) {
#pragma unroll
            for (int r = 0; r < 16; ++r) Gt[(32 * wave + (r & 3) + 8 * (r >> 2) + 4 * hh) * 16 + c] = acc[r]; }
    }
    __syncthreads();
    if (tid < 256) {
        const int t = 256 * blk + tid;
        float g[NBLK];
#pragma unroll
        for (int j4 = 0; j4 < 4; ++j4) { const f32x4 gv = *(const LAS f32x4*)(Gt + tid * 16 + 4 * j4); g[4 * j4] = gv[0]; g[4 * j4 + 1] = gv[1]; g[4 * j4 + 2] = gv[2]; g[4 * j4 + 3] = gv[3]; }
        float v1 = -3e38f, v2 = -3e38f, v3 = -3e38f; int i1 = -1, i2 = -1, i3 = -1;
#pragma unroll
        for (int j = 0; j < NBLK - 1; ++j) if (j < blk) { const float gg = g[j];
            if (gg > v1) { v3 = v2; i3 = i2; v2 = v1; i2 = i1; v1 = gg; i1 = j; } else if (gg > v2) { v3 = v2; i3 = i2; v2 = gg; i2 = j; } else if (gg > v3) { v3 = gg; i3 = j; } }
        unsigned m = 1u << blk; if (i1 >= 0) m |= 1u << i1; if (i2 >= 0) m |= 1u << i2; if (i3 >= 0) m |= 1u << i3;
        M16[(size_t)bh * S_ + t] = m;
        for (int kt = 0; kt < 4 * blk + 4; ++kt) { const int n = t - 64 * kt + 1; const u64 cm = n >= 64 ? ~0ull : (n <= 0 ? 0ull : ((1ull << n) - 1ull));
            MKB[((size_t)bh * 64 + kt) * S_ + t] = ((m >> (kt >> 2)) & 1u) ? cm : 0ull; }
    }
    __syncthreads();
}
__device__ __forceinline__ void p3_index(const Args& a, LAS unsigned char* lds, int vcu, int G, int tid, int lane, int wave) {
    unsigned char* ws = a.ws;
    const h16* QI = (const h16*)(ws + WS_QI); const h16* KI = (const h16*)(ws + WS_KI); const float* WI = (const float*)(ws + WS_WI); u64* MASK = (u64*)(ws + WS_MASK);
    for (int v = vcu; v < 256; v += G) moba_select((const h16*)(ws + WS_QB), (const h16*)(ws + WS_QBL), (const float*)(ws + WS_KMEAN), (unsigned*)(ws + WS_M16), (u64*)(ws + WS_MASKB), lds, v >> 4, v & 15, tid);
    for (int v = vcu; v < 256; v += G) { const int p = v & 127, bp = v >> 7;
#pragma unroll 1
        for (int k = 0; k < 4; ++k) { const int bb = 2 * bp + ((k == 1 || k == 2) ? 1 : 0), ii = (k & 1) ? p : 255 - p; const int cs = k * 256 + v; idx_item(a, (k < 3 && cs < CV_STEPS) ? cs : -1, QI, KI, WI, MASK, lds, bb, ii, tid, lane, wave); } }
}
}


namespace attp {
typedef float f32x16 __attribute__((ext_vector_type(16)));
typedef short s16x4 __attribute__((ext_vector_type(4)));
constexpr int NW = 8, QBLK = 32, KVBLK = 64, QB = NW * QBLK, D = 128, PITCH = 512;
constexpr int SHM_V = KVBLK * D * 2, SHM_K = KVBLK * D * 2;
constexpr int LDS_M = 2 * SHM_V + 2 * SHM_K + NW * 64 * 4;
constexpr int LDS_ATT = LDS_M + 4096;
constexpr int V_SLOT2 = LDS_ATT, LDS_ATT_END = LDS_ATT + SHM_V;
constexpr float SCALE = 0.08838834764831845f, THR = 8.f;
#define KSWZ(row, colB) ((row) * 256 + ((colB) ^ (((row) & 7) << 4)))
#define SBAR() __builtin_amdgcn_sched_barrier(0)
__device__ __forceinline__ int v_st(int k, int c) { const int kk = (k & ~0xC) | ((k & 4) << 1) | ((k & 8) >> 1); return ((kk >> 3) * 4 + (c >> 5)) * 512 + ((kk & 7) * 32 + (c & 31)) * 2; }
__device__ __forceinline__ int v_rd_base(int lane) { return ((lane & 3) << 3) | (((lane >> 2) & 3) << 6) | (((lane >> 4) & 1) << 5) | (((lane >> 5) & 1) << 8); }
constexpr int v_rd_off(int d0, int ks, int half) { return d0 * 512 + ks * 4096 + half * 2048; }
__device__ __forceinline__ int crow(int r, int hi) { return (r & 3) + 8 * (r >> 2) + 4 * hi; }
__device__ __forceinline__ void mask_apply(f32x16& p0, f32x16& p1, u64 mk, int hi) {
    const unsigned lo = (unsigned)mk >> (4 * hi), hw = (unsigned)(mk >> 32) >> (4 * hi);
    const unsigned NEGI = 0xff800000u;
#pragma unroll
    for (int r = 0; r < 16; ++r) { const int c = (r & 3) + 8 * (r >> 2);
        const unsigned t0 = (unsigned)(((int)(lo << (31 - c))) >> 31), t1 = (unsigned)(((int)(hw << (31 - c))) >> 31);
        p0[r] = __uint_as_float((__float_as_uint(p0[r]) & t0) | (NEGI & ~t0));
        p1[r] = __uint_as_float((__float_as_uint(p1[r]) & t1) | (NEGI & ~t1)); }
}
__device__ __forceinline__ void partialSM(f32x16& p0, f32x16& p1, float& m_reg, float& mn, float& alpha) {
    float pmax = p0[0];
#pragma unroll
    for (int r = 1; r < 16; ++r) pmax = fmaxf(pmax, p0[r]);
#pragma unroll
    for (int r = 0; r < 16; ++r) pmax = fmaxf(pmax, p1[r]);
    { auto rr = __builtin_amdgcn_permlane32_swap(__float_as_uint(pmax), __float_as_uint(pmax), false, false);
      pmax = fmaxf(__uint_as_float(rr[0]), __uint_as_float(rr[1])); }
    constexpr float C2 = 1.4426950408889634f * SCALE;
    if (__builtin_expect(__all((pmax - m_reg) * SCALE <= THR), 1)) { mn = m_reg; alpha = 1.f; }
    else { mn = fmaxf(m_reg, pmax); alpha = __builtin_amdgcn_exp2f((m_reg - mn) * C2); m_reg = mn; }
    const float mnL = -mn * C2;
#pragma unroll
    for (int r = 0; r < 16; ++r) p0[r] = fmaf(p0[r], C2, mnL);
#pragma unroll
    for (int r = 0; r < 16; ++r) p1[r] = fmaf(p1[r], C2, mnL);
#pragma unroll
    for (int r = 0; r < 16; ++r) p0[r] = __builtin_amdgcn_exp2f(p0[r]);
}
__device__ __forceinline__ void finishSM(f32x16& p0, f32x16& p1, float alpha, float& l_reg, f16x8& pa0, f16x8& pa1, f16x8& pa2, f16x8& pa3) {
#pragma unroll
    for (int r = 0; r < 16; ++r) p1[r] = __builtin_amdgcn_exp2f(p1[r]);
    float ps = 0;
#pragma unroll
    for (int r = 0; r < 16; ++r) ps += p0[r];
#pragma unroll
    for (int r = 0; r < 16; ++r) ps += p1[r];
    { auto rr = __builtin_amdgcn_permlane32_swap(__float_as_uint(ps), __float_as_uint(ps), false, false);
      ps = __uint_as_float(rr[0]) + __uint_as_float(rr[1]); }
    l_reg = l_reg * alpha + ps;
#define PK4(P, B_, OUT) do { unsigned a0 = pkh(P[B_+0], P[B_+1]), a1 = pkh(P[B_+2], P[B_+3]);                          \
        unsigned b0 = pkh(P[B_+4], P[B_+5]), b1 = pkh(P[B_+6], P[B_+7]);                                             \
        auto r0 = __builtin_amdgcn_permlane32_swap(a0, b0, false, false); auto r1 = __builtin_amdgcn_permlane32_swap(a1, b1, false, false); \
        u32x4 w = {r0[0], r1[0], r0[1], r1[1]}; OUT = __builtin_bit_cast(f16x8, w); } while (0)
    PK4(p0, 0, pa0); PK4(p0, 8, pa1); PK4(p1, 0, pa2); PK4(p1, 8, pa3);
#undef PK4
}
template <int KB>
__device__ __forceinline__ void qkt(f32x16& p0, f32x16& p1, LAS const char* K_lds, int r32, int hi, const f16x8* qr) {
    p0 = f32x16{}; p1 = f32x16{};
    LAS const char* kb[4];
#pragma unroll
    for (int dd = 0; dd < 4; ++dd) kb[dd] = K_lds + KB * SHM_K + KSWZ(r32, (dd * 16 + hi * 8) * 2);
#pragma unroll
    for (int d0 = 0; d0 < 8; ++d0) { LAS const char* a = kb[d0 & 3] + (d0 >> 2) * 128;
        const f16x8 b0 = *(LAS const f16x8*)a;
        const f16x8 b1 = *(LAS const f16x8*)(a + 32 * 256);
        p0 = __builtin_amdgcn_mfma_f32_32x32x16_f16(b0, qr[d0], p0, 0, 0, 0);
        p1 = __builtin_amdgcn_mfma_f32_32x32x16_f16(b1, qr[d0], p1, 0, 0, 0); }
}
template <int VB>
__device__ __forceinline__ void pv_tile(f32x16* o, int vb0, f16x8 pa0, f16x8 pa1, f16x8 pa2, f16x8 pa3) {
#define TRRD(dst, off) asm volatile("ds_read_b64_tr_b16 %0, %1 offset:%2" : "=&v"(dst) : "v"(vb0), "i"(off) : "memory")
#define PV_D0(d0) do { s16x4 l0, l1, l2, l3, h0, h1, h2, h3; constexpr int b_ = VB * SHM_V + v_rd_off(d0, 0, 0); \
        TRRD(l0, b_); TRRD(h0, b_ + 2048); TRRD(l1, b_ + 4096); TRRD(h1, b_ + 6144); TRRD(l2, b_ + 8192); TRRD(h2, b_ + 10240); TRRD(l3, b_ + 12288); TRRD(h3, b_ + 14336); \
        asm volatile("s_waitcnt lgkmcnt(0)" ::: "memory"); SBAR(); \
        o[d0] = __builtin_amdgcn_mfma_f32_32x32x16_f16(pa0, __builtin_bit_cast(f16x8, (short __attribute__((ext_vector_type(8)))){l0[0], l0[1], l0[2], l0[3], h0[0], h0[1], h0[2], h0[3]}), o[d0], 0, 0, 0);   \
        o[d0] = __builtin_amdgcn_mfma_f32_32x32x16_f16(pa1, __builtin_bit_cast(f16x8, (short __attribute__((ext_vector_type(8)))){l1[0], l1[1], l1[2], l1[3], h1[0], h1[1], h1[2], h1[3]}), o[d0], 0, 0, 0);   \
        o[d0] = __builtin_amdgcn_mfma_f32_32x32x16_f16(pa2, __builtin_bit_cast(f16x8, (short __attribute__((ext_vector_type(8)))){l2[0], l2[1], l2[2], l2[3], h2[0], h2[1], h2[2], h2[3]}), o[d0], 0, 0, 0);   \
        o[d0] = __builtin_amdgcn_mfma_f32_32x32x16_f16(pa3, __builtin_bit_cast(f16x8, (short __attribute__((ext_vector_type(8)))){l3[0], l3[1], l3[2], l3[3], h3[0], h3[1], h3[2], h3[3]}), o[d0], 0, 0, 0); } while (0)
    PV_D0(0); PV_D0(1); PV_D0(2); PV_D0(3);
#undef PV_D0
#undef TRRD
}
template <int VB>
__device__ __forceinline__ void pv_sm(f32x16* o, int vb0, f16x8 pa0, f16x8 pa1, f16x8 pa2, f16x8 pa3, f32x16& p0, f32x16& p1, unsigned lo, unsigned hw, float& m_reg, float& mn, float& alpha) {
    const unsigned NEGI = 0xff800000u;
    constexpr float C2 = 1.4426950408889634f * SCALE;
    float pmax, mnL;
#define PIN2(a, b) asm volatile("" : "+v"(a), "+v"(b))
#define TRRD(dst, off) asm volatile("ds_read_b64_tr_b16 %0, %1 offset:%2" : "=&v"(dst) : "v"(vb0), "i"(off) : "memory")
#define PV_RD(d0) s16x4 l0, l1, l2, l3, h0, h1, h2, h3; { constexpr int b_ = VB * SHM_V + v_rd_off(d0, 0, 0); \
        TRRD(l0, b_); TRRD(h0, b_ + 2048); TRRD(l1, b_ + 4096); TRRD(h1, b_ + 6144); TRRD(l2, b_ + 8192); TRRD(h2, b_ + 10240); TRRD(l3, b_ + 12288); TRRD(h3, b_ + 14336); } SBAR()
#define PV_MM(d0) SBAR(); asm volatile("s_waitcnt lgkmcnt(0)" ::: "memory"); SBAR(); \
        o[d0] = __builtin_amdgcn_mfma_f32_32x32x16_f16(pa0, __builtin_bit_cast(f16x8, (short __attribute__((ext_vector_type(8)))){l0[0], l0[1], l0[2], l0[3], h0[0], h0[1], h0[2], h0[3]}), o[d0], 0, 0, 0);   \
        o[d0] = __builtin_amdgcn_mfma_f32_32x32x16_f16(pa1, __builtin_bit_cast(f16x8, (short __attribute__((ext_vector_type(8)))){l1[0], l1[1], l1[2], l1[3], h1[0], h1[1], h1[2], h1[3]}), o[d0], 0, 0, 0);   \
        o[d0] = __builtin_amdgcn_mfma_f32_32x32x16_f16(pa2, __builtin_bit_cast(f16x8, (short __attribute__((ext_vector_type(8)))){l2[0], l2[1], l2[2], l2[3], h2[0], h2[1], h2[2], h2[3]}), o[d0], 0, 0, 0);   \
        o[d0] = __builtin_amdgcn_mfma_f32_32x32x16_f16(pa3, __builtin_bit_cast(f16x8, (short __attribute__((ext_vector_type(8)))){l3[0], l3[1], l3[2], l3[3], h3[0], h3[1], h3[2], h3[3]}), o[d0], 0, 0, 0)
    { PV_RD(0);
#pragma unroll
      for (int r = 0; r < 16; ++r) { const int c = (r & 3) + 8 * (r >> 2); const unsigned t0 = (unsigned)(((int)(lo << (31 - c))) >> 31);
          p0[r] = __uint_as_float((__float_as_uint(p0[r]) & t0) | (NEGI & ~t0)); }
      pmax = p0[0];
#pragma unroll
      for (int r = 1; r < 16; ++r) pmax = fmaxf(pmax, p0[r]);
      PIN2(p0, pmax); PV_MM(0); }
    { PV_RD(1);
#pragma unroll
      for (int r = 0; r < 16; ++r) { const int c = (r & 3) + 8 * (r >> 2); const unsigned t1 = (unsigned)(((int)(hw << (31 - c))) >> 31);
          p1[r] = __uint_as_float((__float_as_uint(p1[r]) & t1) | (NEGI & ~t1)); }
#pragma unroll
      for (int r = 0; r < 16; ++r) pmax = fmaxf(pmax, p1[r]);
      PIN2(p1, pmax); PV_MM(1); }
    { PV_RD(2);
      { auto rr = __builtin_amdgcn_permlane32_swap(__float_as_uint(pmax), __float_as_uint(pmax), false, false);
        pmax = fmaxf(__uint_as_float(rr[0]), __uint_as_float(rr[1])); }
      if (__builtin_expect(__all((pmax - m_reg) * SCALE <= THR), 1)) { mn = m_reg; alpha = 1.f; }
      else { mn = fmaxf(m_reg, pmax); alpha = __builtin_amdgcn_exp2f((m_reg - mn) * C2); m_reg = mn; }
      mnL = -mn * C2;
#pragma unroll
      for (int r = 0; r < 16; ++r) p0[r] = fmaf(p0[r], C2, mnL);
#pragma unroll
      for (int r = 0; r < 16; ++r) p1[r] = fmaf(p1[r], C2, mnL);
      PIN2(p0, p1); PV_MM(2); }
    { PV_RD(3);
#pragma unroll
      for (int r = 0; r < 16; ++r) p0[r] = __builtin_amdgcn_exp2f(p0[r]);
      PIN2(p0, alpha); PV_MM(3); }
#undef PIN2
#undef PV_RD
#undef PV_MM
#undef TRRD
}
struct BlockRef { const h16* Q; const h16* K; const h16* V; h16* O; const u64* MK; int P0; int pad; };
struct Seam { f16x8 qr[8]; f16x8 st_v0, st_v1, st_k0, st_k1; unsigned st_m; };
#define VMW() asm volatile("s_waitcnt vmcnt(0)" ::: "memory")
#define VMWN(n) asm volatile("s_waitcnt vmcnt(%0)" :: "i"(n) : "memory")
#define SLOAD_H(B_, k0) do { const char* kb_ = (const char*)(B_).K + (size_t)(k0) * (PITCH * 2); const char* vb_ = (const char*)(B_).V + (size_t)(k0) * (PITCH * 2);           \
                         S.st_v0 = *(const f16x8*)(vb_ + kvoff); S.st_v1 = *(const f16x8*)(vb_ + 32 * PITCH * 2 + kvoff);                                   \
                         S.st_k0 = *(const f16x8*)(kb_ + kvoff); S.st_k1 = *(const f16x8*)(kb_ + 32 * PITCH * 2 + kvoff);                                   \
                         S.st_m = *(const unsigned*)((const char*)((B_).MK + (size_t)((k0) / KVBLK) * S_ + (B_).P0 + wid * QBLK) + moff); } while (0)
#define SWRITE_HK(bf) do { *(LAS f16x8*)(K_lds + (bf) * SHM_K + kws) = S.st_k0; *(LAS f16x8*)(K_lds + (bf) * SHM_K + kws + 32 * 256) = S.st_k1; } while (0)
#define SWRITE_HV(voff, bf) do { *(LAS f16x8*)(V_lds + (voff) + vst0) = S.st_v0; *(LAS f16x8*)(V_lds + (voff) + vst1) = S.st_v1; \
                           *(LAS unsigned*)(lds + LDS_M + (bf) * 2048 + wid * 256 + lane * 4) = S.st_m; } while (0)
#define SWRITE_H(voff, bf) do { SWRITE_HV(voff, bf); SWRITE_HK(bf); } while (0)
__device__ __forceinline__ void attn_prime(const BlockRef& cur, LAS char* lds, Seam& S) {
    int tid = threadIdx.x; asm volatile("" : "+v"(tid));
    const int wid = __builtin_amdgcn_readfirstlane(tid >> 6), lane = tid & 63, r32 = lane & 31, hi = lane >> 5;
    const int sr = tid >> 4, sc = (tid & 15) * 8, kws = KSWZ(sr, sc * 2); LAS char* K_lds = lds + 2 * SHM_V;
    const unsigned kvoff = (unsigned)(sr * PITCH + sc) * 2u, moff = (unsigned)lane * 4u, qoff = (unsigned)((wid * QBLK + r32) * PITCH + hi * 8) * 2u;
#pragma unroll
    for (int d0 = 0; d0 < 8; ++d0) S.qr[d0] = *(const f16x8*)((const char*)cur.Q + qoff + d0 * 32);
    SLOAD_H(cur, 0); VMW(); SWRITE_HK(0);
    __syncthreads();
}
__device__ __forceinline__ void attn_block(const BlockRef& cur, const BlockRef& nxt, LAS char* lds, Seam& S) {
    int tid = threadIdx.x; asm volatile("" : "+v"(tid));
    const int wid = __builtin_amdgcn_readfirstlane(tid >> 6), lane = tid & 63, r32 = lane & 31, hi = lane >> 5;
    const unsigned kvoff = (unsigned)((tid >> 4) * PITCH + (tid & 15) * 8) * 2u, moff = (unsigned)lane * 4u, qoff = (unsigned)((wid * QBLK + r32) * PITCH + hi * 8) * 2u;
    const int NT = cur.P0 / KVBLK + 4;
    LAS char* V_lds = lds; LAS char* K_lds = lds + 2 * SHM_V;
    LAS float* wsf = (LAS float*)(lds + 2 * SHM_V + 2 * SHM_K) + wid * 64; LAS float* li_l = wsf; LAS float* al_l = wsf + 32;
    float m_reg = -1e30f, l_reg = 0; f32x16 o[4] = {};
    const int sr = tid >> 4, sc = (tid & 15) * 8, vst0 = v_st(sr, sc), vst1 = v_st(32 + sr, sc), kws = KSWZ(sr, sc * 2);
    const int vb0 = (int)(unsigned)(uintptr_t)V_lds + v_rd_base(lane);
#define RESC(a) do { if (__any((a) < 1.f)) { if (hi == 0) al_l[r32] = (a); asm volatile("s_waitcnt lgkmcnt(0)" ::: "memory");              \
                     _Pragma("unroll") for (int d_ = 0; d_ < 4; ++d_) _Pragma("unroll") for (int r = 0; r < 16; ++r) o[d_][r] *= al_l[crow(r, hi)]; } } while (0)
#define KBASE(t) ((t) * KVBLK)
#define MKGET(bf) (*(const LAS u64*)(lds + LDS_M + (bf) * 2048 + wid * 256 + r32 * 8))
#define SEAM_K0() do { VMWN(8); SWRITE_HK(0); SBAR(); } while (0)
    f32x16 pA0, pA1, pB0, pB1; float mnA, mnB, alA, alB; f16x8 pa0, pa1, pa2, pa3;
    SWRITE_HV(0, 0); SBAR();
    if (NT > 1) SLOAD_H(cur, KBASE(1));
    SBAR(); qkt<0>(pA0, pA1, K_lds, r32, hi, S.qr);
    mask_apply(pA0, pA1, MKGET(0), hi); partialSM(pA0, pA1, m_reg, mnA, alA);
    if (NT > 1) { VMW(); SWRITE_H(SHM_V, 1); }
    __syncthreads();
    int va = 0, vn = SHM_V, vc = V_SLOT2;
#define HALF_STEP(PX0, PX1, mnX, alX, PY0, PY1, alY, t, KB, VB, SB) do {                                                      \
        SBAR(); unsigned mlo_, mhw_; { const u64 mk_ = MKGET(KB); mlo_ = (unsigned)mk_ >> (4 * hi); mhw_ = (unsigned)(mk_ >> 32) >> (4 * hi); } \
        qkt<KB>(PX0, PX1, K_lds, r32, hi, S.qr);                                                                               \
        finishSM(PY0, PY1, alY, l_reg, pa0, pa1, pa2, pa3); asm volatile("" : "+v"(mlo_), "+v"(mhw_)); SBAR();               \
        if ((t) + 1 < NT) { SLOAD_H(cur, KBASE((t) + 1)); SBAR(); }                                                        \
        pv_sm<0>(o, vb0 + va, pa0, pa1, pa2, pa3, PX0, PX1, mlo_, mhw_, m_reg, mnX, alX);                                          \
        if ((t) + 1 < NT) { VMW(); SWRITE_H(vc, SB); }                                                                        \
        RESC(alX); __syncthreads(); { const int t_ = va; va = vn; vn = vc; vc = t_; } } while (0)
    for (int t = 1; t + 1 < NT; t += 2) {
        HALF_STEP(pB0, pB1, mnB, alB, pA0, pA1, alA, t, 1, 0, 0);
        HALF_STEP(pA0, pA1, mnA, alA, pB0, pB1, alB, t + 1, 0, 1, 1);
    }
    const bool even = (NT & 1) == 0;
    if (even) { SBAR(); qkt<1>(pB0, pB1, K_lds, r32, hi, S.qr); SBAR(); }
    SLOAD_H(nxt, 0); SBAR();
#pragma unroll
    for (int d0 = 0; d0 < 8; ++d0) S.qr[d0] = *(const f16x8*)((const char*)nxt.Q + qoff + d0 * 32);
    SBAR();
    finishSM(pA0, pA1, alA, l_reg, pa0, pa1, pa2, pa3); SBAR();
    pv_tile<0>(o, vb0 + va, pa0, pa1, pa2, pa3);
    if (even) { mask_apply(pB0, pB1, MKGET(1), hi); partialSM(pB0, pB1, m_reg, mnB, alB); __syncthreads(); RESC(alB);
        finishSM(pB0, pB1, alB, l_reg, pa0, pa1, pa2, pa3); SBAR(); pv_tile<0>(o, vb0 + vn, pa0, pa1, pa2, pa3); }
    SBAR(); SEAM_K0();
    if (hi == 0) li_l[r32] = l_reg; asm volatile("s_waitcnt lgkmcnt(0)" ::: "memory");
    float rli[16];
#pragma unroll
    for (int r = 0; r < 16; ++r) rli[r] = __builtin_amdgcn_rcpf(li_l[crow(r, hi)]);
    char* Ow = (char*)cur.O + (size_t)(wid * QBLK) * (PITCH * 2); const unsigned ooff = (unsigned)(4 * hi * PITCH + r32) * 2u;
#pragma unroll
    for (int r = 0; r < 16; ++r) { const int orow = (r & 3) + 8 * (r >> 2);
#pragma unroll
        for (int d0 = 0; d0 < 4; ++d0) { const float v = o[d0][r] * rli[r];
            const float vn = __shfl_xor(v, 1);
            if ((r32 & 1) == 0) *(unsigned*)(Ow + (size_t)(orow * PITCH + d0 * 32) * 2 + ooff) = pkh(v, vn); } }
    __syncthreads();
#undef RESC
#undef KBASE
#undef MKGET
#undef SEAM_K0
#undef HALF_STEP
}
#undef VMW
#undef VMWN
#undef SLOAD_H
#undef SWRITE_HK
#undef SWRITE_HV
#undef SWRITE_H
__device__ __forceinline__ BlockRef make_ref(unsigned char* ws, int kind, int b, int h, int qb) {
    BlockRef r; const size_t ro = (size_t)(b * S_) * PITCH + h * D;
    const h16* Q = (const h16*)(ws + (kind ? WS_QB : WS_QA)); const h16* K = (const h16*)(ws + (kind ? WS_KB : WS_KA)); const h16* V = (const h16*)(ws + (kind ? WS_VB : WS_VA));
    h16* O = (h16*)(ws + (kind ? WS_QBL : WS_QI));
    r.Q = Q + ro + (size_t)(qb * QB) * PITCH; r.K = K + ro; r.V = V + ro; r.O = O + ro + (size_t)(qb * QB) * PITCH;
    r.MK = kind ? (const u64*)(ws + WS_MASKB) + (size_t)(b * NH + h) * 64 * S_ : (const u64*)(ws + WS_MASK) + (size_t)b * 64 * S_; r.P0 = qb * QB; r.pad = 0;
    return r;
}
__device__ __forceinline__ void p4_attention(const Args& a, LAS unsigned char* lds, int vcu, int G) {
    for (int v = vcu; v < 256; v += G) {
        const int kind = v >> 7, bh = (v & 127) >> 3, s = v & 7;
        const BlockRef r0 = make_ref(a.ws, kind, bh >> 2, bh & 3, 15 - s), r1 = make_ref(a.ws, kind, bh >> 2, bh & 3, s);
        Seam S;
        attn_prime(r0, (LAS char*)lds, S);
        for (int pass = 0; pass < 2; ++pass) { const BlockRef cur = pass ? r1 : r0; attn_block(cur, r1, (LAS char*)lds, S); }
    }
}
#undef KSWZ
#undef SBAR
}

constexpr int NPHASE = 9;
__global__ void __launch_bounds__(NWAVES * 64, 2) mega_fwd(Args args) {
    extern __shared__ __attribute__((aligned(16))) unsigned char lds_raw[];
    LAS unsigned char* lds = (LAS unsigned char*)lds_raw;
    volatile LAS unsigned* MISC = (volatile LAS unsigned*)(lds + MISC_OFF);
    const int tid = threadIdx.x, lane = tid & 63, wave = __builtin_amdgcn_readfirstlane(tid >> 6);
    const int G = gridDim.x, bx = blockIdx.x, vcu = (G % 8 == 0) ? (bx % 8) * (G / 8) + bx / 8 : bx;
    unsigned char* ws = args.ws;
    if (tid < 16) MISC[tid] = 0u;
    __syncthreads();
    const int lo = args.ph_lo, hi = args.ph_hi;
    const bool multi = hi - lo > 1;
    XcdBarrier bar; bar.bar = (unsigned*)(ws + WS_CTL) + 1024 + args.li * XCD_BAR_WORDS; bar.x = 0; bar.st = nullptr;
    if (multi) bar = xcd_barrier_post((unsigned*)(ws + WS_CTL) + 1024 + args.li * XCD_BAR_WORDS, MISC + 8);
#define IN(k) (lo <= (k) && (k) < hi)
    bool fast = false;
    unsigned nlb = 0;
#define SEAM_LOCAL(k) ((k) == 1 || (k) == 5 || (k) == 6 || (k) == 7)
#define SEAM(k) do { if (IN(k) && IN((k) + 1)) { if (fast && SEAM_LOCAL(k)) xcd_local_barrier(bar, nlb++); else xcd_barrier(bar); } } while (0)
    if (IN(0)) { p0_prologue(args, lds, vcu, G, tid, lane, wave); SEAM(0);
        if (lo == 0 && hi == NPHASE && G == 256) {     if (tid == 0) MISC[12] = xb_ld(&bar.bar[XB_MIS]) == 0u ? 1u : 0u; __syncthreads(); fast = MISC[12] != 0u; } }
    if (IN(1)) { p1_hn(args, vcu, G, lane, wave); SEAM(1); }
    if (IN(2)) {
        pg8::Gemm g{(const h16*)(ws + WS_HN), (const h16*)(ws + WS_HN), (const h16*)(ws + WS_WIN), (const h16*)(ws + WS_WIN), 1024};
        pg8::StaticOrder S; S.init(T_, NIN, G, bx);
        EpiInProj E{args.flags & 1, ws, (h16*)args.out};
        fill_rope_deltas(ws, lds + SCR_OFF, tid);
        pg8::gemm_phase(lds, g, S, E); SEAM(2);
    }
    if (IN(3)) { idxp::p3_index(args, lds, vcu, G, tid, lane, wave); SEAM(3); }
    if (IN(4)) { p5_bias2(args, vcu, G, lane, wave); attp::p4_attention(args, lds, vcu, G); SEAM(4); }
    if (IN(5)) {
        pg8::Gemm g{(const h16*)(ws + WS_QI), (const h16*)(ws + WS_QBL), (const h16*)(ws + WS_WA), (const h16*)(ws + WS_WB), 512};
        pg8::StaticOrder S; S.init(T_, 1024, G, bx, 2);
        EpiBranch E{(const h16*)args.out, (const h16*)args.out + (size_t)T_ * 1024, (h16*)(ws + WS_HN)};
        pg8::gemm_phase(lds, g, S, E);
        if (fast) { asm volatile("s_waitcnt vmcnt(0)" ::: "memory"); __syncthreads(); if (tid == 0) (void)xb_add(&bar.bar[XB_P5D], 1u); }
        SEAM(5);
    }
    if (IN(6)) {
        pg8::Gemm g{(const h16*)(ws + WS_HN), (const h16*)(ws + WS_HN), (const h16*)(ws + WS_WOUT), (const h16*)(ws + WS_WOUT), 1024};
        pg8::StaticOrder S; S.init(T_, 1024, G, bx);
        EpiOut E{args.x, args.g_ffn, (const float*)(ws + WS_MOD), ws, (h16*)(ws + WS_A2), (float*)(ws + WS_SSQ)};
        pg8::gemm_phase(lds, g, S, E); SEAM(6);
    }
    if (IN(7)) {
        pg8::Gemm g{(const h16*)(ws + WS_A2), (const h16*)(ws + WS_A2), (const h16*)(ws + WS_WGU), (const h16*)(ws + WS_WGU), 1024};
        pg8::StaticOrder S; S.init(T_, NGU, G, bx);
        const bool tail = G == 256;
        if (tail) S.cap = 5 * 256;
        EpiGUT<2> E{args.flags & 1, (const float*)(ws + WS_SSQ), (const float*)(ws + WS_BIAS2), (h16*)(ws + WS_ACT)};
        pg8::gemm_phase(lds, g, S, E);
        if (tail) {
            pg8::Gemm gh{(const h16*)(ws + WS_A2), (const h16*)(ws + WS_A2) + (size_t)128 * 1024, (const h16*)(ws + WS_WGU), (const h16*)(ws + WS_WGU), 1024};
            pg8::HalfTail H{S, bx};
            EpiGUT<1> Eh{args.flags & 1, (const float*)(ws + WS_SSQ), (const float*)(ws + WS_BIAS2), (h16*)(ws + WS_ACT)};
            pg8::gemm_phase<EpiGUT<1>, pg8::HalfTail, true>(lds, gh, H, Eh);
        }
        SEAM(7);
    }
    if (IN(8)) {
        if (fast) { if (tid == 0) XB_SPIN(xb_ld(&bar.bar[XB_P5D]) < (unsigned)G, bar.bar); __syncthreads(); }
        pg8::Gemm g{(const h16*)(ws + WS_ACT), (const h16*)(ws + WS_ACT), (const h16*)(ws + WS_WDN), (const h16*)(ws + WS_WDN), DFF};
        pg8::StaticOrder S; S.init(T_, 1024, G, bx);
        EpiDown E{(const float*)(ws + WS_MOD), ws, args.out};
        pg8::gemm_phase(lds, g, S, E);
    }
#undef IN
#undef SEAM
}

#ifndef MEGA_P2
#define MEGA_P2 0
#endif
#ifndef MEGA_P34
#define MEGA_P34 0
#endif
#ifndef MEGA_P5
#define MEGA_P5 0
#endif
#ifndef MEGA_P1
#define MEGA_P1 1
#endif
#ifndef MEGA_P67
#define MEGA_P67 1
#endif
#ifndef MEGA_P8
#define MEGA_P8 1
#endif
#ifndef ONE_LAUNCH
#define ONE_LAUNCH 0
#endif

__global__ void __launch_bounds__(256) a2ssq_naive(const float* x1, const float* g_ffn, const float* MOD, h16* A2, float* SSQ) {
    const int row = blockIdx.x, b = row / S_, tid = threadIdx.x; __shared__ float red[256];
    float v[4]; float s = 0;
    for (int j = 0; j < 4; ++j) { v[j] = x1[(size_t)row * D_ + tid + 256 * j]; s += v[j] * v[j]; }
    red[tid] = s; __syncthreads();
    for (int o = 128; o > 0; o >>= 1) { if (tid < o) red[tid] += red[tid + o]; __syncthreads(); }
#if DBG_A2
    for (int j = 0; j < 4; ++j) { const int k = tid + 256 * j; A2[(size_t)row * D_ + k] = (h16)(v[j] * g_ffn[k] * (1.f + MOD[b * 6144 + 4096 + k])); }
#endif
#if DBG_SSQ
    if (tid < 16) SSQ[(size_t)row * 16 + tid] = tid == 0 ? red[0] : 0.f;
#endif
}
__global__ void __launch_bounds__(256) bias2_naive(const float* MOD, const float* w_gate_up, float* BIAS2) {
    const int idx = blockIdx.x * 256 + threadIdx.x; if (idx >= 4 * NGU) return; const int b = idx / NGU, cp = idx % NGU; const int src = MapGU{}(cp);
    float s = 0; for (int k = 0; k < D_; ++k) s += MOD[b * 6144 + 3072 + k] * w_gate_up[(size_t)k * NGU + src];
    BIAS2[idx] = s;
}
extern "C" void kernel_launch(void* const* d_in, const int* in_sizes, int n_in, void* d_out, int out_size, void* d_ws, size_t ws_size, hipStream_t stream) {
    static int grid = 0;
    if (grid == 0) {
        int dev = 0, cus = 0;
        if (hipGetDevice(&dev) != hipSuccess || hipDeviceGetAttribute(&cus, hipDeviceAttributeMultiprocessorCount, dev) != hipSuccess) { fprintf(stderr, "kernel_launch: device query failed\n"); grid = -1; return; }
        if (hipFuncSetAttribute((const void*)mega_fwd, hipFuncAttributeMaxDynamicSharedMemorySize, LDS_BYTES) != hipSuccess) { fprintf(stderr, "kernel_launch: hipFuncSetAttribute failed\n"); grid = -1; return; }
        (void)hipGetLastError();
        grid = cus;
        if (ws_size < 256 * MiB) { fprintf(stderr, "kernel_launch: workspace too small\n"); grid = -1; return; }
    }
    if (grid < 0) return;
    const float* x = (const float*)d_in[0]; const float* c = (const float*)d_in[1]; const float* w_mod = (const float*)d_in[2]; const float* b_mod = (const float*)d_in[3];
    const float* g_mix = (const float*)d_in[4]; const float* g_ffn = (const float*)d_in[5]; const float* w_in = (const float*)d_in[6];
    const float* g_q_dsa = (const float*)d_in[7]; const float* g_k_dsa = (const float*)d_in[8]; const float* g_q_moba = (const float*)d_in[9]; const float* g_k_moba = (const float*)d_in[10];
    const float* w_br_dsa = (const float*)d_in[11]; const float* w_br_moba = (const float*)d_in[12]; const float* w_out = (const float*)d_in[13];
    const float* w_gate_up = (const float*)d_in[14]; const float* w_down = (const float*)d_in[15];
    unsigned char* ws = (unsigned char*)d_ws; float* out = (float*)d_out;
    float* MOD = (float*)(ws + WS_MOD); float* KMEAN = (float*)(ws + WS_KMEAN); unsigned* M16 = (unsigned*)(ws + WS_M16); float* WI = (float*)(ws + WS_WI);
    h16* KI = (h16*)(ws + WS_KI); u64* MASK = (u64*)(ws + WS_MASK); h16* HN = (h16*)(ws + WS_HN);
    h16 *QA = (h16*)(ws + WS_QA), *KA = (h16*)(ws + WS_KA), *VA = (h16*)(ws + WS_VA), *QI = (h16*)(ws + WS_QI), *QB = (h16*)(ws + WS_QB), *KB = (h16*)(ws + WS_KB), *VB = (h16*)(ws + WS_VB), *QBL = (h16*)(ws + WS_QBL);
    float* TMP = (float*)(ws + WS_TMP); float* TMP2 = (float*)(ws + WS_TMP2); h16* MERGED = (h16*)(ws + WS_HN);
    h16* GA = (h16*)d_out; h16* GB = GA + (size_t)T_ * D_;
    h16* OA = QI; h16* OB = QBL;
    (void)MOD; (void)w_mod; (void)b_mod; (void)c; (void)g_mix; (void)g_ffn; (void)w_out; (void)w_gate_up; (void)w_down;

    if (hipMemsetAsync((char*)d_ws + WS_CTL, 0, CTL_ZERO_BYTES, stream) != hipSuccess) { fprintf(stderr, "kernel_launch: memset failed\n"); return; }
    Args a{};
    a.x = x; a.c = c; a.w_mod = w_mod; a.b_mod = b_mod; a.g_mix = g_mix; a.g_ffn = g_ffn; a.w_in = w_in; a.g_q_dsa = g_q_dsa; a.g_k_dsa = g_k_dsa; a.g_q_moba = g_q_moba; a.g_k_moba = g_k_moba;
    a.w_br_dsa = w_br_dsa; a.w_br_moba = w_br_moba; a.w_out = w_out; a.w_gate_up = w_gate_up; a.w_down = w_down; a.out = out; a.ws = ws;
#define MEGA(lo_, hi_) do { a.ph_lo = (lo_); a.ph_hi = (hi_); hipLaunchKernelGGL(mega_fwd, dim3(grid), dim3(NWAVES * 64), LDS_BYTES, stream, a); } while (0)
#if ONE_LAUNCH
#ifdef PROBE_NOEPI
    a.li = 1; MEGA(0, PROBE_NOEPI); a.flags = PROBE_FLAG; MEGA(PROBE_NOEPI, PROBE_NOEPI + 1); a.flags = 0; a.li = 0;
#endif
#ifdef PROBE_K
    a.li = 1; MEGA(0, PROBE_K); a.li = 0;
#endif
    MEGA(0, NPHASE);
#else
    MEGA(0, 1);
#if MEGA_P1
    MEGA(1, 2);
#else
    mod_naive<<<24, 256, 0, stream>>>(c, w_mod, b_mod, MOD);
    normmod_naive<<<T_, 256, 0, stream>>>(x, g_mix, MOD, 0, 1024, HN);
#endif
#if MEGA_P2
    MEGA(2, 3);
#else
    {
    const dim3 g512(8, T_ / 64);
    gemm_naive<false, EpiF32><<<g512, 256, 0, stream>>>(HN, D_, w_in, INW, C_QA, 0, 512, D_, EpiF32{TMP, 512});
    heads_post_naive<<<T_, 256, 0, stream>>>(TMP, 512, g_q_dsa, 4, 128, QA, 512, nullptr, 0);
    gemm_naive<false, EpiF32><<<g512, 256, 0, stream>>>(HN, D_, w_in, INW, C_KA, 0, 512, D_, EpiF32{TMP, 512});
    heads_post_naive<<<T_, 256, 0, stream>>>(TMP, 512, g_k_dsa, 4, 128, KA, 512, nullptr, 0);
    gemm_naive<false, EpiH><<<g512, 256, 0, stream>>>(HN, D_, w_in, INW, C_VA, 0, 512, D_, EpiH{VA, 512});
    gemm_naive<false, EpiF32><<<g512, 256, 0, stream>>>(HN, D_, w_in, INW, C_QI, 0, 512, D_, EpiF32{TMP, 512});
    heads_post_naive<<<T_, 256, 0, stream>>>(TMP, 512, nullptr, 8, 64, QI, 512, nullptr, 0);
    gemm_naive<false, EpiF32><<<dim3(2, T_ / 64), 256, 0, stream>>>(HN, D_, w_in, INW, C_KI, 0, 72, D_, EpiF32{TMP, 72});
    kiwi_post_naive<<<T_, 64, 0, stream>>>(TMP, KI, WI);
    gemm_naive<false, EpiF32><<<g512, 256, 0, stream>>>(HN, D_, w_in, INW, C_QB, 0, 512, D_, EpiF32{TMP, 512});
    heads_post_naive<<<T_, 256, 0, stream>>>(TMP, 512, g_q_moba, 4, 128, QB, 512, QBL, 0);
    gemm_naive<false, EpiF32><<<g512, 256, 0, stream>>>(HN, D_, w_in, INW, C_KB, 0, 512, D_, EpiF32{TMP, 512});
    heads_post_naive<<<T_, 256, 0, stream>>>(TMP, 512, g_k_moba, 4, 128, KB, 512, nullptr, 1);
    kmean_naive<<<NB * NH * NBLK, 128, 0, stream>>>(TMP, KMEAN);
    gemm_naive<false, EpiH><<<g512, 256, 0, stream>>>(HN, D_, w_in, INW, C_VB, 0, 512, D_, EpiH{VB, 512});
    const dim3 g1024(16, T_ / 64);
    gemm_naive<false, EpiSigH><<<g1024, 256, 0, stream>>>(HN, D_, w_in, INW, C_GA, 0, 1024, D_, EpiSigH{GA, D_});
    gemm_naive<false, EpiSigH><<<g1024, 256, 0, stream>>>(HN, D_, w_in, INW, C_GB, 0, 1024, D_, EpiSigH{GB, D_});
    }
#endif
#if MEGA_P34 == 1
    MEGA(3, 4); MEGA(4, 5);
#elif MEGA_P34 == 2
    MEGA(3, 4);
    dsa_attn_naive<<<T_, 256, 0, stream>>>(QA, KA, VA, MASK, OA);
    moba_attn_naive<<<T_, 256, 0, stream>>>(QB, KB, VB, M16, OB);
#else
    idx_topk_naive<<<T_, 256, 0, stream>>>(QI, KI, WI, MASK);
    moba_sel_naive<<<NB * NH * S_ / 256, 256, 0, stream>>>(QB, QBL, KMEAN, M16);
    dsa_attn_naive<<<T_, 256, 0, stream>>>(QA, KA, VA, MASK, OA);
    moba_attn_naive<<<T_, 256, 0, stream>>>(QB, KB, VB, M16, OB);
#endif
#if MEGA_P5
    MEGA(5, 6);
#else
    {
    const dim3 g1024(16, T_ / 64);
    gemm_naive<false, EpiGateF32><<<g1024, 256, 0, stream>>>(OA, 512, w_br_dsa, D_, 0, 0, 1024, 512, EpiGateF32{GA, TMP2, 0});
    gemm_naive<false, EpiGateH><<<g1024, 256, 0, stream>>>(OB, 512, w_br_moba, D_, 0, 0, 1024, 512, EpiGateH{GB, TMP2, MERGED});
    }
#endif
#if MEGA_P67 == 1
    MEGA(6, 7); MEGA(7, 8);
#elif MEGA_P67 == 3
    MEGA(6, 7);
    a2ssq_naive<<<T_, 256, 0, stream>>>(out, g_ffn, MOD, (h16*)(ws + WS_A2), (float*)(ws + WS_SSQ));
#if DBG_B2
    bias2_naive<<<(4 * NGU + 255) / 256, 256, 0, stream>>>(MOD, w_gate_up, (float*)(ws + WS_BIAS2));
#endif
    MEGA(7, 8);
#elif MEGA_P67 == 2
    { MEGA(6, 7); h16* H2 = (h16*)(ws + WS_A2); h16* ACT = (h16*)(ws + WS_ACT);
    normmod_naive<<<T_, 256, 0, stream>>>(out, g_ffn, MOD, 3072, 4096, H2);
    gemm_naive<true, EpiSwiglu><<<dim3(DFF / 64, T_ / 64), 256, 0, stream>>>(H2, D_, w_gate_up, 2 * DFF, 0, DFF, DFF, D_, EpiSwiglu{ACT}); }
#else
    {
    const dim3 g1024(16, T_ / 64); h16* H2 = (h16*)(ws + WS_A2); h16* ACT = (h16*)(ws + WS_ACT);
    gemm_naive<false, EpiRes><<<g1024, 256, 0, stream>>>(MERGED, D_, w_out, D_, 0, 0, 1024, D_, EpiRes{x, MOD, out, 2048});
    normmod_naive<<<T_, 256, 0, stream>>>(out, g_ffn, MOD, 3072, 4096, H2);
    gemm_naive<true, EpiSwiglu><<<dim3(DFF / 64, T_ / 64), 256, 0, stream>>>(H2, D_, w_gate_up, 2 * DFF, 0, DFF, DFF, D_, EpiSwiglu{ACT});
    }
#endif
#if MEGA_P8
    MEGA(8, 9);
#else
    { const dim3 g1024(16, T_ / 64); h16* ACT = (h16*)(ws + WS_ACT);
    gemm_naive<false, EpiRes><<<g1024, 256, 0, stream>>>(ACT, DFF, w_down, D_, 0, 0, 1024, DFF, EpiRes{out, MOD, out, 5120}); }
#endif
#endif
}
```
